# Optimizing an MI355X kernel written in HIP

```python
import math
import jax, jax.numpy as jnp
from jax import lax
import numpy as np


D_MODEL = 1024
BATCH = 8
SEQ = 2048
DEPTH = 2

GRID_W = 64
CTX_LEN = 256

D_MIX = D_MODEL
A_WIDTH = D_MODEL // 4
A_GROUPS = 4
A_GD = A_WIDTH // A_GROUPS
CHUNK = 128
B_WIDTH = D_MODEL // 4
CONV_W = 3
C_WIDTH = D_MODEL // 2
ATT_HEADS = 4
V_DIM = C_WIDTH // ATT_HEADS
QK_DIM = V_DIM // 2
ROPE_BASE = 10000.0
Q_BLOCK = 128

OFF_AU = 0
OFF_AV = OFF_AU + A_WIDTH
OFF_BB = OFF_AV + A_WIDTH
OFF_BC = OFF_BB + B_WIDTH
OFF_BX = OFF_BC + B_WIDTH
OFF_Q = OFF_BX + B_WIDTH
OFF_K = OFF_Q + 2 * ATT_HEADS * QK_DIM
OFF_V = OFF_K + 2 * ATT_HEADS * QK_DIM
D_IN = OFF_V + C_WIDTH

N_EXPERTS = 64
TOP_K = 8
D_EXPERT = D_MODEL // 4
D_SHARED = D_MODEL // 4
ROUTED_SCALE = 2.5

EPS = 1e-6

kernel_name = "hybrid_dit_gmlp_conv_diffattn_moe"


def rmsnorm(x, g):
    xf = x.astype(jnp.float32)
    y = xf * lax.rsqrt(jnp.mean(xf * xf, axis=-1, keepdims=True) + EPS)
    return y.astype(x.dtype) * g


def axial_rope_tables(rows):
    row = jnp.repeat(jnp.arange(rows), GRID_W).astype(jnp.float32)
    col = jnp.tile(jnp.arange(GRID_W), rows).astype(jnp.float32)
    n_freq = QK_DIM // 4
    inv = ROPE_BASE ** (-jnp.arange(n_freq, dtype=jnp.float32) / n_freq)
    ang_r = row[:, None] * inv
    ang_c = col[:, None] * inv
    return (jnp.cos(ang_r), jnp.sin(ang_r), jnp.cos(ang_c), jnp.sin(ang_c))


def rope_half(x, cos, sin):
    x1, x2 = jnp.split(x, 2, axis=-1)
    cos = cos.astype(x.dtype)
    sin = sin.astype(x.dtype)
    return jnp.concatenate([x1 * cos - x2 * sin, x2 * cos + x1 * sin], axis=-1)


def axial_rope(x, tabs):
    cr, sr, cc, sc = tabs
    xr, xc = jnp.split(x, 2, axis=-1)
    return jnp.concatenate([rope_half(xr, cr, sr), rope_half(xc, cc, sc)], axis=-1)


def chunk_gmlp(u, v, g_v, w_s, b_s):
    bn, L, _ = v.shape
    v = rmsnorm(v, g_v).reshape(bn, L // CHUNK, CHUNK, A_GROUPS, A_GD)
    v = jnp.einsum('gpq,bnqgd->bnpgd', w_s, v) + b_s.T[:, :, None]
    return u * v.reshape(bn, L, A_WIDTH)


def short_conv(bg, cg, xin, w_conv):
    z = cg * xin
    y = lax.conv_general_dilated(z, w_conv[:, None, :], window_strides=(1,), padding=((1, 1),),
                                 dimension_numbers=('NWC', 'WIO', 'NWC'),
                                 feature_group_count=B_WIDTH)
    return bg * y


def qk_heads(t, g):
    bn, L, _ = t.shape
    t = t.reshape(bn, L, 2, ATT_HEADS, QK_DIM).transpose(2, 0, 3, 1, 4)
    return rmsnorm(t, g)


def v_heads(t):
    bn, L, _ = t.shape
    return t.reshape(bn, L, ATT_HEADS, V_DIM).transpose(0, 2, 1, 3)


def diff_attend(q1, q2, k1, k2, v, lam):
    scale = QK_DIM ** -0.5
    s1 = jnp.einsum('bhqd,bhkd->bhqk', q1, k1, preferred_element_type=jnp.float32) * scale
    s2 = jnp.einsum('bhqd,bhkd->bhqk', q2, k2, preferred_element_type=jnp.float32) * scale
    w = jax.nn.softmax(s1, axis=-1) - lam.astype(jnp.float32) * jax.nn.softmax(s2, axis=-1)
    return jnp.einsum('bhqk,bhkd->bhqd', w.astype(v.dtype), v)


def token_mixers(h, hc, w_in, w_out, g_v, w_s, b_s, w_conv, g_q, g_k,
                 lam_q1, lam_k1, lam_q2, lam_k2, g_sub, lam_init, tabs, last):
    bn, L, _ = h.shape
    lam = jnp.exp(jnp.sum(lam_q1 * lam_k1)) - jnp.exp(jnp.sum(lam_q2 * lam_k2)) + lam_init

    def local_mixers(p):
        u, v = jnp.split(jax.nn.gelu(p[..., OFF_AU:OFF_BB], approximate=False), 2, axis=-1)
        ya = chunk_gmlp(u, v, g_v, w_s, b_s)
        yb = short_conv(p[..., OFF_BB:OFF_BC], p[..., OFF_BC:OFF_BX], p[..., OFF_BX:OFF_Q], w_conv)
        return ya, yb

    def head_out(y):
        return (rmsnorm(y, g_sub) * (1.0 - lam_init)).reshape(y.shape[0], y.shape[1], C_WIDTH)

    kv_c = hc @ w_in[:, OFF_K:]
    k_c = qk_heads(kv_c[..., :OFF_V - OFF_K], g_k)
    v_c = v_heads(kv_c[..., OFF_V - OFF_K:])

    p = h @ w_in
    ya, yb = local_mixers(p)
    q = axial_rope(qk_heads(p[..., OFF_Q:OFF_K], g_q), tabs)
    k_l = axial_rope(qk_heads(p[..., OFF_K:OFF_V], g_k), tabs)
    v_l = v_heads(p[..., OFF_V:D_IN])
    k_all = jnp.concatenate([k_c, k_l], axis=3)
    v_all = jnp.concatenate([v_c, v_l], axis=2)
    nb = L // Q_BLOCK
    qb = q.reshape(2, bn, ATT_HEADS, nb, Q_BLOCK, QK_DIM).transpose(3, 0, 1, 2, 4, 5)
    yq = lax.map(lambda qq: diff_attend(qq[0], qq[1], k_all[0], k_all[1], v_all, lam), qb)
    yq = yq.transpose(1, 0, 3, 2, 4).reshape(bn, L, ATT_HEADS, V_DIM)
    y = jnp.concatenate([ya, yb, head_out(yq)], axis=-1) @ w_out
    if last:
        return y, None

    pc = hc @ w_in[:, :OFF_K]
    ya_c, yb_c = local_mixers(pc)
    q_c = qk_heads(pc[..., OFF_Q:OFF_K], g_q)
    yq_c = diff_attend(q_c[0], q_c[1], k_c[0], k_c[1], v_c, lam).transpose(0, 2, 1, 3)
    yc = jnp.concatenate([ya_c, yb_c, head_out(yq_c)], axis=-1) @ w_out
    return y, yc


def moe(t, w_router, b_router, w_gate, w_up, w_down, ws_gate, ws_up, ws_down):
    scores = jax.nn.sigmoid((t @ w_router).astype(jnp.float32))
    _, idx = lax.top_k(scores + b_router.astype(jnp.float32), TOP_K)
    sel = jnp.take_along_axis(scores, idx, axis=-1)
    sel = sel / jnp.sum(sel, axis=-1, keepdims=True) * ROUTED_SCALE
    gates = jnp.einsum('nk,nke->ne', sel, jax.nn.one_hot(idx, N_EXPERTS, dtype=jnp.float32)).astype(t.dtype)
    shared = (jax.nn.silu(t @ ws_gate) * (t @ ws_up)) @ ws_down

    def expert_step(acc, e):
        wg, wu, wd, ge = e
        hid = jax.nn.silu(t @ wg) * (t @ wu)
        return acc + (ge[:, None] * hid) @ wd, None

    out, _ = lax.scan(expert_step, shared, (w_gate, w_up, w_down, gates.T))
    return out


def setup_inputs(seed: int = 0) -> dict:
    key = jax.random.key(seed)
    ks = jax.random.split(key, 32)
    D = D_MODEL

    def nrm(k, shape, s):
        return jax.random.normal(k, shape, jnp.float32) * s

    return {
        "x": nrm(ks[0], (BATCH, SEQ, D), 1.0),
        "c": nrm(ks[1], (BATCH, D), 1.0),
        "ctx": nrm(ks[2], (BATCH, CTX_LEN, D), 1.0),
        "c_ctx": nrm(ks[3], (D,), 1.0),
        "w_ada": nrm(ks[4], (DEPTH, D, 6 * D), 0.5 * D ** -0.5),
        "b_ada": nrm(ks[5], (DEPTH, 6 * D), 0.02),
        "g_norm1": 1.0 + nrm(ks[6], (DEPTH, D), 0.02),
        "g_norm2": 1.0 + nrm(ks[7], (DEPTH, D), 0.02),
        "w_in": nrm(ks[8], (DEPTH, D, D_IN), D ** -0.5),
        "w_out": nrm(ks[9], (DEPTH, D_MIX, D), D_MIX ** -0.5),
        "g_v": 1.0 + nrm(ks[10], (DEPTH, A_WIDTH), 0.02),
        "w_s": nrm(ks[11], (DEPTH, A_GROUPS, CHUNK, CHUNK), CHUNK ** -0.5),
        "b_s": 1.0 + nrm(ks[12], (DEPTH, A_GROUPS, CHUNK), 0.1),
        "w_conv": nrm(ks[13], (DEPTH, CONV_W, B_WIDTH), CONV_W ** -0.5),
        "g_q": 1.0 + nrm(ks[14], (DEPTH, QK_DIM), 0.02),
        "g_k": 1.0 + nrm(ks[15], (DEPTH, QK_DIM), 0.02),
        "lam_q1": nrm(ks[16], (DEPTH, QK_DIM), 0.1),
        "lam_k1": nrm(ks[17], (DEPTH, QK_DIM), 0.1),
        "lam_q2": nrm(ks[18], (DEPTH, QK_DIM), 0.1),
        "lam_k2": nrm(ks[19], (DEPTH, QK_DIM), 0.1),
        "g_sub": 1.0 + nrm(ks[20], (DEPTH, V_DIM), 0.02),
        "w_router": nrm(ks[21], (DEPTH, D, N_EXPERTS), D ** -0.5),
        "b_router": nrm(ks[22], (DEPTH, N_EXPERTS), 0.01),
        "w_gate": nrm(ks[23], (DEPTH, N_EXPERTS, D, D_EXPERT), D ** -0.5),
        "w_up": nrm(ks[24], (DEPTH, N_EXPERTS, D, D_EXPERT), D ** -0.5),
        "w_down": nrm(ks[25], (DEPTH, N_EXPERTS, D_EXPERT, D), D_EXPERT ** -0.5),
        "ws_gate": nrm(ks[26], (DEPTH, D, D_SHARED), D ** -0.5),
        "ws_up": nrm(ks[27], (DEPTH, D, D_SHARED), D ** -0.5),
        "ws_down": nrm(ks[28], (DEPTH, D_SHARED, D), D_SHARED ** -0.5),
    }


def reference(x, c, ctx, c_ctx, w_ada, b_ada, g_norm1, g_norm2, w_in, w_out, g_v, w_s, b_s,
              w_conv, g_q, g_k, lam_q1, lam_k1, lam_q2, lam_k2, g_sub, w_router, b_router,
              w_gate, w_up, w_down, ws_gate, ws_up, ws_down):
    bn, L, D = x.shape
    rows = L // GRID_W
    tabs = axial_rope_tables(rows)
    xc = ctx
    for l in range(DEPTH):
        last = l == DEPTH - 1
        lam_init = 0.8 - 0.6 * math.exp(-0.3 * l)
        mod = (jax.nn.silu(c) @ w_ada[l] + b_ada[l])[:, None, :]
        mod_c = jax.nn.silu(c_ctx) @ w_ada[l] + b_ada[l]
        sh1, sc1, g1, sh2, sc2, g2 = jnp.split(mod, 6, axis=-1)
        csh1, csc1, cg1, csh2, csc2, cg2 = jnp.split(mod_c, 6, axis=-1)

        h = rmsnorm(x, g_norm1[l]) * (1.0 + sc1) + sh1
        hc = rmsnorm(xc, g_norm1[l]) * (1.0 + csc1) + csh1
        y, yc = token_mixers(h, hc, w_in[l], w_out[l], g_v[l], w_s[l], b_s[l], w_conv[l],
                             g_q[l], g_k[l], lam_q1[l], lam_k1[l], lam_q2[l], lam_k2[l],
                             g_sub[l], lam_init, tabs, last)
        x = x + g1 * y
        h2 = rmsnorm(x, g_norm2[l]) * (1.0 + sc2) + sh2
        if last:
            f = moe(h2.reshape(-1, D), w_router[l], b_router[l], w_gate[l], w_up[l], w_down[l],
                    ws_gate[l], ws_up[l], ws_down[l])
            x = x + g2 * f.reshape(bn, L, D)
        else:
            xc = xc + cg1 * yc
            h2c = rmsnorm(xc, g_norm2[l]) * (1.0 + csc2) + csh2
            t = jnp.concatenate([h2.reshape(-1, D), h2c.reshape(-1, D)], axis=0)
            f = moe(t, w_router[l], b_router[l], w_gate[l], w_up[l], w_down[l],
                    ws_gate[l], ws_up[l], ws_down[l])
            x = x + g2 * f[:bn * L].reshape(bn, L, D)
            xc = xc + cg2 * f[bn * L:].reshape(bn, -1, D)
    return x
```

```cpp
#include <hip/hip_runtime.h>
#include <cstdio>
#include <cstdint>

#define LAS __attribute__((address_space(3)))
typedef unsigned short bf16_t;
typedef float f32x4 __attribute__((ext_vector_type(4)));

constexpr int D = 1024, NB = 8, SEQ = 2048, CTXL = 256;
constexpr int RL = NB * SEQ, RC = NB * CTXL, RT = RL + RC;
constexpr int DIN = 2816, OFF_AU = 0, OFF_AV = 256, OFF_BB = 512, OFF_BC = 768, OFF_BX = 1024, OFF_Q = 1280, OFF_K = 1792, OFF_V = 2304;
constexpr int NE = 64, TOPK = 8, DE = 256;
constexpr float EPS = 1e-6f;
constexpr int NTHREADS = 512, NWAVES = 8;

constexpr size_t MiB = 1u << 20;
constexpr size_t WS_CTL = 0, CTL_ZERO_BYTES = 1 * MiB;
constexpr size_t WS_MOD = 1 * MiB;
constexpr size_t WS_XC = 2 * MiB;
constexpr size_t WS_LIST = 10 * MiB;
constexpr size_t WS_WIN = 20 * MiB;
constexpr size_t WS_WOUT = 31 * MiB;
constexpr size_t WS_WR = 35 * MiB;
constexpr size_t WS_WSB = 35 * MiB + 512 * 1024;
constexpr size_t WS_WEXP = 36 * MiB;
constexpr size_t WEXP_STRIDE = 1572864, WEXP_DOWN = 1048576, WEXP_LAYER = 98 * MiB;
constexpr size_t WS_HID = 232 * MiB;
constexpr size_t WS_Y = 280 * MiB;
constexpr size_t WS_HB = 322 * MiB;
constexpr size_t WS_ROWS = 358 * MiB;
constexpr size_t WS_PB = 358 * MiB;
constexpr size_t WS_MIX = 457 * MiB;
constexpr size_t WS_END = 520 * MiB;
constexpr float ROWS_SCALE = 8.0f;
constexpr int HID_SHARED_BASE = 163840;
constexpr int ROPE_OFF = 2 * 9 * 6144 + 64;
constexpr int CW_BAR = 4096;
constexpr int CW_CNT = 16384;
constexpr int CW_CVT = 20480;

#define XB_TMO      128
#define XB_XCNT(j)  (256  + 64 * (j))
#define XB_XSUB(j)  (1280 + 64 * (j))
#define XB_XGEN(j)  (2304 + 64 * (j))
#define XB_TOP      3328
#define XB_TOPGEN   3392
#define XCD_BAR_WORDS 3456
#define XB_SPIN_CAP (1u << 18)
__device__ __forceinline__ unsigned xb_ld(unsigned* p)              { return __hip_atomic_load(p, __ATOMIC_RELAXED, __HIP_MEMORY_SCOPE_AGENT); }
__device__ __forceinline__ unsigned xb_add(unsigned* p, unsigned v) { return __hip_atomic_fetch_add(p, v, __ATOMIC_RELAXED, __HIP_MEMORY_SCOPE_AGENT); }
__device__ __forceinline__ unsigned xb_xcc_id() { return (unsigned)__builtin_amdgcn_s_getreg((3 << 11) | 20) & 0xFu; }
#define XB_SPIN(cond, bar) do { unsigned _sp = 0; while (cond) { __builtin_amdgcn_s_sleep(1); \
    if ((++_sp & 255u) == 0u) { if (xb_ld(&(bar)[XB_TMO])) break; if (_sp > XB_SPIN_CAP) { atomicAdd(&(bar)[XB_TMO], 1u); break; } } } } while (0)
struct XcdBarrier { unsigned* bar; unsigned x; volatile LAS unsigned* st; };
__device__ __forceinline__ XcdBarrier xcd_barrier_post(unsigned* bar, volatile LAS unsigned* st) {
    XcdBarrier b; b.bar = bar; b.x = xb_xcc_id(); b.st = st;
    if (threadIdx.x == 0) (void)xb_add(&bar[XB_XCNT(b.x)], 1u);
    return b;
}
__device__ __forceinline__ void xcd_barrier_complete(unsigned* bar, unsigned x, unsigned& nloc, unsigned& nx) {
    const unsigned G = gridDim.x * gridDim.y * gridDim.z;
    unsigned sum, cnt, mine, sp = 0u;
    for (;;) {
        sum = 0u; cnt = 0u; mine = 0u;
#pragma unroll
        for (unsigned j = 0; j < 16; ++j) { const unsigned c = xb_ld(&bar[XB_XCNT(j)]); sum += c; cnt += (c > 0u) ? 1u : 0u; mine = (j == x) ? c : mine; }
        if (sum == G) break;
        __builtin_amdgcn_s_sleep(1);
        if ((++sp & 255u) == 0u) { if (xb_ld(&bar[XB_TMO])) break; if (sp > XB_SPIN_CAP) { atomicAdd(&bar[XB_TMO], 1u); break; } }
    }
    nloc = mine > 0u ? mine : 1u; nx = cnt > 0u ? cnt : 1u;
}
__device__ __forceinline__ void xcd_barrier(const XcdBarrier& b) {
    asm volatile("s_waitcnt vmcnt(0)" ::: "memory");
    __syncthreads();
    if (threadIdx.x == 0) {
        unsigned* bar = b.bar;
        __builtin_amdgcn_s_waitcnt(0);
        unsigned nloc = b.st[0], nx = b.st[1];
        if (nloc == 0u) { xcd_barrier_complete(bar, b.x, nloc, nx); b.st[0] = nloc; b.st[1] = nx; }
        const unsigned old = xb_add(&bar[XB_XSUB(b.x)], 1u);
        const unsigned gen = old / nloc;
        if (old + 1u == (gen + 1u) * nloc) {
            __builtin_amdgcn_fence(__ATOMIC_RELEASE, "agent");
            asm volatile("s_waitcnt vmcnt(0)" ::: "memory");
            const unsigned og = xb_add(&bar[XB_TOP], 1u);
            const unsigned tg = og / nx;
            if (og + 1u == (tg + 1u) * nx) xb_add(&bar[XB_TOPGEN], 1u);
            else XB_SPIN(xb_ld(&bar[XB_TOPGEN]) == tg, bar);
            __builtin_amdgcn_fence(__ATOMIC_ACQUIRE, "agent");
            xb_add(&bar[XB_XGEN(b.x)], 1u);
            asm volatile("s_waitcnt vmcnt(0)" ::: "memory");
        } else {
            XB_SPIN(xb_ld(&bar[XB_XGEN(b.x)]) == gen, bar);
            __builtin_amdgcn_fence(__ATOMIC_ACQUIRE, "agent");
            asm volatile("s_waitcnt vmcnt(0)" ::: "memory");
        }
    }
    __syncthreads();
}

__device__ __forceinline__ float bf2f(bf16_t v) { return __uint_as_float(((unsigned)v) << 16); }
__device__ __forceinline__ bf16_t f2bf(float f) { unsigned u = __float_as_uint(f); u += 0x7fffu + ((u >> 16) & 1u); return (bf16_t)(u >> 16); }
__device__ __forceinline__ float wave_sum(float v) {
#pragma unroll
    for (int o = 1; o < 64; o <<= 1) v += __shfl_xor(v, o);
    return v;
}
__device__ __forceinline__ float wave_max(float v) {
#pragma unroll
    for (int o = 1; o < 64; o <<= 1) v = fmaxf(v, __shfl_xor(v, o));
    return v;
}
__device__ __forceinline__ float gelu_exact(float v) { return 0.5f * v * (1.0f + erff(v * 0.70710678118654752f)); }
__device__ __forceinline__ float silu_f(float v) { return v / (1.0f + __expf(-v)); }

__device__ __forceinline__ int opaque_tid() { int t = threadIdx.x; asm volatile("" : "+v"(t)); return t; }
struct Params {
    const float* in[29];
    float* out;
    unsigned char* ws;
};
typedef const __attribute__((address_space(4))) Params* KP;
enum { I_X = 0, I_C, I_CTX, I_CCTX, I_WADA, I_BADA, I_GN1, I_GN2, I_WIN, I_WOUT, I_GV, I_WS, I_BS, I_WCONV, I_GQ, I_GK, I_LQ1, I_LK1, I_LQ2, I_LK2, I_GSUB,
       I_WROUTER, I_BROUTER, I_WGATE, I_WUP, I_WDOWN, I_SGATE, I_SUP, I_SDOWN };

__device__ __forceinline__ int row_bb(int r) { return r < RL ? (r / SEQ) : 8; }

constexpr int SG_BM = 128, SG_BN = 128, SG_BK = 16;
template <bool A_BF16, bool DUAL>
__device__ __forceinline__ void sgemm_tile(LAS float* sm, const void* Abase, int lda, const LAS int* rowidx, const float* B, const float* B2, int ldb, int n0, int K,
                                           float (&acc)[4][8], float (&acc2)[4][8], const int tid) {
    LAS float* As = sm;
    LAS float* Bs = sm + 16 * 132;
    LAS float* Bs2 = Bs + 16 * 128;
    const int ty = tid >> 4, tx = tid & 15;
#pragma unroll
    for (int i = 0; i < 4; ++i)
#pragma unroll
        for (int j = 0; j < 8; ++j) { acc[i][j] = 0.f; acc2[i][j] = 0.f; }
    const int am = tid >> 2, ak = (tid & 3) * 4;
    const int arow = rowidx[am];
    const int bk = tid >> 5, bn = (tid & 31) * 4;
    for (int k0 = 0; k0 < K; k0 += SG_BK) {
        float a0 = 0.f, a1 = 0.f, a2 = 0.f, a3 = 0.f;
        if (arow >= 0) {
            if (A_BF16) { const bf16_t* ap = (const bf16_t*)Abase + (size_t)arow * lda + k0 + ak; const uint2 w = *(const uint2*)ap;
                a0 = __uint_as_float(w.x << 16); a1 = __uint_as_float(w.x & 0xffff0000u); a2 = __uint_as_float(w.y << 16); a3 = __uint_as_float(w.y & 0xffff0000u); }
            else { const float* ap = (const float*)Abase + (size_t)arow * lda + k0 + ak; const f32x4 w = *(const f32x4*)ap; a0 = w.x; a1 = w.y; a2 = w.z; a3 = w.w; }
        }
        const f32x4 bv = *(const f32x4*)(B + (size_t)(k0 + bk) * ldb + n0 + bn);
        f32x4 bv2 = {0.f, 0.f, 0.f, 0.f};
        if (DUAL) bv2 = *(const f32x4*)(B2 + (size_t)(k0 + bk) * ldb + n0 + bn);
        __syncthreads();
        As[(ak + 0) * 132 + am] = a0; As[(ak + 1) * 132 + am] = a1; As[(ak + 2) * 132 + am] = a2; As[(ak + 3) * 132 + am] = a3;
        *(LAS f32x4*)(Bs + bk * 128 + bn) = bv;
        if (DUAL) *(LAS f32x4*)(Bs2 + bk * 128 + bn) = bv2;
        __syncthreads();
#pragma unroll
        for (int k = 0; k < SG_BK; ++k) {
            const f32x4 av = *(const LAS f32x4*)(As + k * 132 + ty * 4);
            const f32x4 b0 = *(const LAS f32x4*)(Bs + k * 128 + tx * 8), b1 = *(const LAS f32x4*)(Bs + k * 128 + tx * 8 + 4);
            const float a[4] = {av.x, av.y, av.z, av.w}; const float b[8] = {b0.x, b0.y, b0.z, b0.w, b1.x, b1.y, b1.z, b1.w};
#pragma unroll
            for (int i = 0; i < 4; ++i)
#pragma unroll
                for (int j = 0; j < 8; ++j) acc[i][j] = fmaf(a[i], b[j], acc[i][j]);
            if (DUAL) {
                const f32x4 c0 = *(const LAS f32x4*)(Bs2 + k * 128 + tx * 8), c1 = *(const LAS f32x4*)(Bs2 + k * 128 + tx * 8 + 4);
                const float c[8] = {c0.x, c0.y, c0.z, c0.w, c1.x, c1.y, c1.z, c1.w};
#pragma unroll
                for (int i = 0; i < 4; ++i)
#pragma unroll
                    for (int j = 0; j < 8; ++j) acc2[i][j] = fmaf(a[i], c[j], acc2[i][j]);
            }
        }
    }
    __syncthreads();
}

__device__ __forceinline__ void phase_mod(KP p, LAS float* sm) {
    const int tid = opaque_tid(), lane = tid & 63, wave = tid >> 6;
    float* MOD = (float*)(p->ws + WS_MOD);
    LAS float* sc = sm;
    LAS float* red = sm + 9 * 1024;
    for (int i = tid; i < 9 * 1024; i += NTHREADS) { const int bb = i >> 10, k = i & 1023; const float v = bb < 8 ? p->in[I_C][bb * D + k] : p->in[I_CCTX][k]; sc[i] = silu_f(v); }
    __syncthreads();
    for (int u = blockIdx.x; u < 2 * 96; u += gridDim.x) {
        const int l = u / 96, j0 = (u % 96) * 64;
        const float* W = p->in[I_WADA] + (size_t)l * D * 6144;
        float acc[9];
#pragma unroll
        for (int b = 0; b < 9; ++b) acc[b] = 0.f;
        for (int k0 = wave * 128; k0 < wave * 128 + 128; k0 += 16) {
            float wv[16];
#pragma unroll
            for (int q = 0; q < 16; ++q) wv[q] = __builtin_nontemporal_load(W + (size_t)(k0 + q) * 6144 + j0 + lane);
#pragma unroll
            for (int q = 0; q < 16; ++q)
#pragma unroll
                for (int b = 0; b < 9; ++b) acc[b] = fmaf(sc[b * 1024 + k0 + q], wv[q], acc[b]);
        }
#pragma unroll
        for (int b = 0; b < 9; ++b) red[(wave * 9 + b) * 64 + lane] = acc[b];
        __syncthreads();
        for (int i = tid; i < 9 * 64; i += NTHREADS) { const int b = i >> 6, c = i & 63; float s = 0.f;
#pragma unroll
            for (int w = 0; w < 8; ++w) s += red[(w * 9 + b) * 64 + c];
            MOD[((size_t)l * 9 + b) * 6144 + j0 + c] = s + p->in[I_BADA][l * 6144 + j0 + c]; }
        __syncthreads();
    }
    {
        bf16_t* WRT = (bf16_t*)(p->ws + WS_WR); bf16_t* WSB = (bf16_t*)(p->ws + WS_WSB);
        for (int i = blockIdx.x * NTHREADS + tid; i < 2 * 64 * 1024; i += gridDim.x * NTHREADS) {
            const int ll = i >> 16, e = (i >> 10) & 63, k = i & 1023;
            WRT[i] = f2bf(p->in[I_WROUTER][((size_t)ll * D + k) * NE + e]);
            WSB[i] = f2bf(p->in[I_WS][i]);
        }
    }
    {
        for (int i = blockIdx.x * NTHREADS + tid; i < 64 * 16; i += gridDim.x * NTHREADS) { const int pos = i >> 4, f = i & 15;
            const float invf = powf(10000.0f, -(float)f / 16.0f); const float ang = (float)pos * invf;
            MOD[ROPE_OFF + pos * 32 + f] = cosf(ang); MOD[ROPE_OFF + pos * 32 + 16 + f] = sinf(ang); }
    }
    if (blockIdx.x == 0 && wave == 0) {
        for (int l = 0; l < 2; ++l) {
            const float a = wave_sum(p->in[I_LQ1][l * 64 + lane] * p->in[I_LK1][l * 64 + lane]);
            const float b = wave_sum(p->in[I_LQ2][l * 64 + lane] * p->in[I_LK2][l * 64 + lane]);
            const float lam_init = 0.8f - 0.6f * expf(-0.3f * (float)l);
            if (lane == 0) MOD[2 * 9 * 6144 + l] = expf(a) - expf(b) + lam_init;
        }
    }
}

__device__ __forceinline__ const float* xsrc_row(KP p, int l, int r) {
    if (l == 0) return r < RL ? p->in[I_X] + (size_t)r * D : p->in[I_CTX] + (size_t)(r - RL) * D;
    return r < RL ? p->out + (size_t)r * D : (const float*)(p->ws + WS_XC) + (size_t)(r - RL) * D;
}
__device__ __forceinline__ float* xw_row(KP p, int r) {
    return r < RL ? p->out + (size_t)r * D : (float*)(p->ws + WS_XC) + (size_t)(r - RL) * D;
}

__device__ __forceinline__ void norm_row(const float* src, const float* gn, const float* scv, const float* shv, bf16_t* dst, int lane, float (&hv)[16]) {
    f32x4 v[4]; float ss = 0.f;
#pragma unroll
    for (int j = 0; j < 4; ++j) { v[j] = *(const f32x4*)(src + lane * 4 + 256 * j); ss += v[j].x * v[j].x + v[j].y * v[j].y + v[j].z * v[j].z + v[j].w * v[j].w; }
    ss = wave_sum(ss);
    const float inv = rsqrtf(ss * (1.0f / D) + EPS);
#pragma unroll
    for (int j = 0; j < 4; ++j) {
        const int c = lane * 4 + 256 * j;
        const f32x4 g = *(const f32x4*)(gn + c), s1 = *(const f32x4*)(scv + c), s0 = *(const f32x4*)(shv + c);
        const float h0 = v[j].x * inv * g.x * (1.f + s1.x) + s0.x, h1 = v[j].y * inv * g.y * (1.f + s1.y) + s0.y;
        const float h2 = v[j].z * inv * g.z * (1.f + s1.z) + s0.z, h3 = v[j].w * inv * g.w * (1.f + s1.w) + s0.w;
        hv[4 * j + 0] = h0; hv[4 * j + 1] = h1; hv[4 * j + 2] = h2; hv[4 * j + 3] = h3;
        uint2 w; w.x = (unsigned)f2bf(h0) | ((unsigned)f2bf(h1) << 16); w.y = (unsigned)f2bf(h2) | ((unsigned)f2bf(h3) << 16);
        *(uint2*)(dst + c) = w;
    }
}
__device__ __forceinline__ void phase_norm1(KP p, int l) {
    const int tid = opaque_tid(), lane = tid & 63, gw = blockIdx.x * NWAVES + (tid >> 6), NGW = gridDim.x * NWAVES;
    const float* MOD = (const float*)(p->ws + WS_MOD) + (size_t)l * 9 * 6144;
    bf16_t* HB = (bf16_t*)(p->ws + WS_HB);
    const float* gn = p->in[I_GN1] + l * D;
    for (int r0 = gw; r0 < RT; r0 += 3 * NGW) {
        f32x4 v[3][4];
#pragma unroll
        for (int q = 0; q < 3; ++q) { const int r = r0 + q * NGW; if (r < RT) { const float* s = xsrc_row(p, l, r) + lane * 4;
#pragma unroll
            for (int j = 0; j < 4; ++j) v[q][j] = __builtin_nontemporal_load((const f32x4*)(s + 256 * j)); } }
#pragma unroll
        for (int q = 0; q < 3; ++q) { const int r = r0 + q * NGW; if (r < RT) {
            const int bb = row_bb(r); float ss = 0.f;
#pragma unroll
            for (int j = 0; j < 4; ++j) ss += v[q][j].x * v[q][j].x + v[q][j].y * v[q][j].y + v[q][j].z * v[q][j].z + v[q][j].w * v[q][j].w;
            ss = wave_sum(ss);
            const float inv = rsqrtf(ss * (1.0f / D) + EPS);
#pragma unroll
            for (int j = 0; j < 4; ++j) { const int c = lane * 4 + 256 * j;
                const f32x4 g = *(const f32x4*)(gn + c), s1 = *(const f32x4*)(MOD + bb * 6144 + 1024 + c), s0 = *(const f32x4*)(MOD + bb * 6144 + c);
                const f32x4 h = v[q][j] * inv * g * (1.0f + s1) + s0;
                uint2 w; w.x = (unsigned)f2bf(h.x) | ((unsigned)f2bf(h.y) << 16); w.y = (unsigned)f2bf(h.z) | ((unsigned)f2bf(h.w) << 16);
                *(uint2*)(HB + (size_t)r * D + c) = w; }
        } }
    }
}

__device__ __forceinline__ void phase_inproj(KP p, int l, LAS float* sm) {
    const int tid = opaque_tid(), ty = tid >> 4, tx = tid & 15;
    LAS int* rowidx = (LAS int*)(sm + 16 * 132 + 2 * 16 * 128);
    const bf16_t* HB = (const bf16_t*)(p->ws + WS_HB); bf16_t* PB = (bf16_t*)(p->ws + WS_PB);
    const float* W = p->in[I_WIN] + (size_t)l * D * DIN;
    const int nMt = RT / 128, nNt = DIN / 128;
    for (int u = blockIdx.x; u < nMt * nNt; u += gridDim.x) {
        const int mt = u / nNt, nt = u % nNt;
        if (tid < 128) rowidx[tid] = mt * 128 + tid;
        __syncthreads();
        float acc[4][8], acc2[4][8];
        sgemm_tile<true, false>(sm, HB, D, rowidx, W, nullptr, DIN, nt * 128, D, acc, acc2, tid);
#pragma unroll
        for (int i = 0; i < 4; ++i) { const int r = mt * 128 + ty * 4 + i;
#pragma unroll
            for (int j = 0; j < 8; ++j) { const int c = nt * 128 + tx * 8 + j; float v = acc[i][j]; if (c < 512) v = gelu_exact(v); PB[(size_t)r * DIN + c] = f2bf(v); } }
    }
}

__device__ __forceinline__ void phase_mixers(KP p, int l, LAS float* sm, const bool do_gmlp) {
    const int tid = opaque_tid(), lane = tid & 63, wave = tid >> 6;
    bf16_t* PB = (bf16_t*)(p->ws + WS_PB); bf16_t* MIX = (bf16_t*)(p->ws + WS_MIX);
    if (do_gmlp) {
        LAS float* vn = sm;
        LAS float* wsm = sm + 128 * 64;
        LAS float* rinv = wsm + 128 * 129;
        const int nchunks = (l == 0 ? RT : RL) / 128;
        const float* gv = p->in[I_GV] + l * 256;
        for (int u = blockIdx.x; u < nchunks * 4; u += gridDim.x) {
            const int ch = u >> 2, g = u & 3, r0 = ch * 128;
            for (int q = wave * 16; q < wave * 16 + 16; ++q) {
                const bf16_t* vr = PB + (size_t)(r0 + q) * DIN + OFF_AV + lane * 4;
                const uint2 w = *(const uint2*)vr;
                const float a = __uint_as_float(w.x << 16), b = __uint_as_float(w.x & 0xffff0000u), c = __uint_as_float(w.y << 16), d = __uint_as_float(w.y & 0xffff0000u);
                const float ss = wave_sum(a * a + b * b + c * c + d * d);
                if (lane == 0) rinv[q] = rsqrtf(ss * (1.0f / 256.0f) + EPS);
            }
            const float* wsrc = p->in[I_WS] + ((size_t)l * 4 + g) * 128 * 128;
            for (int i = tid; i < 128 * 128; i += NTHREADS) wsm[(i >> 7) * 129 + (i & 127)] = wsrc[i];
            __syncthreads();
            for (int i = tid; i < 128 * 64; i += NTHREADS) { const int q = i >> 6, d = i & 63;
                vn[i] = bf2f(PB[(size_t)(r0 + q) * DIN + OFF_AV + g * 64 + d]) * rinv[q] * gv[g * 64 + d]; }
            __syncthreads();
            const int pp = tid >> 2, d0 = (tid & 3) * 16;
            float acc[16];
#pragma unroll
            for (int i = 0; i < 16; ++i) acc[i] = 0.f;
            for (int q = 0; q < 128; ++q) {
                const float w = wsm[pp * 129 + q];
#pragma unroll
                for (int i4 = 0; i4 < 4; ++i4) { const f32x4 x = *(const LAS f32x4*)(vn + q * 64 + d0 + i4 * 4);
                    acc[i4 * 4 + 0] = fmaf(w, x.x, acc[i4 * 4 + 0]); acc[i4 * 4 + 1] = fmaf(w, x.y, acc[i4 * 4 + 1]); acc[i4 * 4 + 2] = fmaf(w, x.z, acc[i4 * 4 + 2]); acc[i4 * 4 + 3] = fmaf(w, x.w, acc[i4 * 4 + 3]); }
            }
            const float bias = p->in[I_BS][(l * 4 + g) * 128 + pp];
#pragma unroll
            for (int i = 0; i < 16; ++i) { const int c = g * 64 + d0 + i; const float uu = bf2f(PB[(size_t)(r0 + pp) * DIN + OFF_AU + c]);
                MIX[(size_t)(r0 + pp) * D + c] = f2bf(uu * (acc[i] + bias)); }
            __syncthreads();
        }
    }
    {
        const int gw = blockIdx.x * NWAVES + wave, NGW = gridDim.x * NWAVES;
        const float* wc = p->in[I_WCONV] + l * 3 * 256;
        const float* gq = p->in[I_GQ] + l * 64; const float* gk = p->in[I_GK] + l * 64;
        const float* ROPE = (const float*)(p->ws + WS_MOD) + ROPE_OFF;
        const int c = lane * 4, vid = lane >> 2, qt = lane & 3;
        const float* gg = vid < 8 ? gq : gk;
        constexpr int NR = 3;
        for (int r0 = gw; r0 < RT; r0 += NR * NGW) {
            uint2 cgv[NR][3], xiv[NR][3], bgv[NR]; uint4 qk0[NR], qk1[NR];
#pragma unroll
            for (int q = 0; q < NR; ++q) { const int r = r0 + q * NGW; if (r < RT) {
                const bool lat = r < RL; const int t = lat ? (r % SEQ) : ((r - RL) % CTXL); const int slen = lat ? SEQ : CTXL;
#pragma unroll
                for (int d = 0; d < 3; ++d) { const int rr = (t + d - 1 >= 0 && t + d - 1 < slen) ? r + d - 1 : r; const bf16_t* rp = PB + (size_t)rr * DIN;
                    cgv[q][d] = *(const uint2*)(rp + OFF_BC + c); xiv[q][d] = *(const uint2*)(rp + OFF_BX + c); }
                bgv[q] = *(const uint2*)(PB + (size_t)r * DIN + OFF_BB + c);
                const bf16_t* vp = PB + (size_t)r * DIN + OFF_Q + vid * 64 + qt * 16;
                qk0[q] = *(const uint4*)vp; qk1[q] = *(const uint4*)(vp + 8); } }
#pragma unroll
            for (int q = 0; q < NR; ++q) { const int r = r0 + q * NGW; if (r < RT) {
                const bool lat = r < RL; const int t = lat ? (r % SEQ) : ((r - RL) % CTXL); const int slen = lat ? SEQ : CTXL;
                if (lat || l == 0) {
                    float z[3][4];
#pragma unroll
                    for (int d = 0; d < 3; ++d) { const float ok = (t + d - 1 >= 0 && t + d - 1 < slen) ? 1.0f : 0.0f; const uint2 cg = cgv[q][d], xi = xiv[q][d];
                        z[d][0] = ok * __uint_as_float(cg.x << 16) * __uint_as_float(xi.x << 16); z[d][1] = ok * __uint_as_float(cg.x & 0xffff0000u) * __uint_as_float(xi.x & 0xffff0000u);
                        z[d][2] = ok * __uint_as_float(cg.y << 16) * __uint_as_float(xi.y << 16); z[d][3] = ok * __uint_as_float(cg.y & 0xffff0000u) * __uint_as_float(xi.y & 0xffff0000u); }
                    const uint2 bg = bgv[q];
                    const float bgf[4] = {__uint_as_float(bg.x << 16), __uint_as_float(bg.x & 0xffff0000u), __uint_as_float(bg.y << 16), __uint_as_float(bg.y & 0xffff0000u)};
                    float y[4];
#pragma unroll
                    for (int i = 0; i < 4; ++i) y[i] = bgf[i] * (wc[0 * 256 + c + i] * z[0][i] + wc[1 * 256 + c + i] * z[1][i] + wc[2 * 256 + c + i] * z[2][i]);
                    uint2 w; w.x = (unsigned)f2bf(y[0]) | ((unsigned)f2bf(y[1]) << 16); w.y = (unsigned)f2bf(y[2]) | ((unsigned)f2bf(y[3]) << 16);
                    *(uint2*)(MIX + (size_t)r * D + 256 + c) = w;
                }
                {
                    bf16_t* vp = PB + (size_t)r * DIN + OFF_Q + vid * 64 + qt * 16;
                    const uint4 w0 = qk0[q], w1 = qk1[q];
                    const unsigned ww[8] = {w0.x, w0.y, w0.z, w0.w, w1.x, w1.y, w1.z, w1.w};
                    float e[16]; float ss = 0.f;
#pragma unroll
                    for (int i = 0; i < 8; ++i) { e[2 * i] = __uint_as_float(ww[i] << 16); e[2 * i + 1] = __uint_as_float(ww[i] & 0xffff0000u); ss += e[2 * i] * e[2 * i] + e[2 * i + 1] * e[2 * i + 1]; }
                    ss += __shfl_xor(ss, 1); ss += __shfl_xor(ss, 2);
                    const float inv = rsqrtf(ss * (1.0f / 64.0f) + EPS);
#pragma unroll
                    for (int i = 0; i < 16; ++i) e[i] = e[i] * inv * gg[qt * 16 + i];
                    if (lat) {
                        const int pos = (qt < 2) ? (t / 64) : (t % 64);
                        const float* rt = ROPE + pos * 32;
#pragma unroll
                        for (int i4 = 0; i4 < 4; ++i4) {
                            const f32x4 cs4 = *(const f32x4*)(rt + i4 * 4), sn4 = *(const f32x4*)(rt + 16 + i4 * 4);
                            const float csv[4] = {cs4.x, cs4.y, cs4.z, cs4.w}, snv[4] = {sn4.x, sn4.y, sn4.z, sn4.w};
#pragma unroll
                            for (int ii = 0; ii < 4; ++ii) { const int i = i4 * 4 + ii;
                                const float other = __shfl_xor(e[i], 1);
                                e[i] = (qt & 1) ? (e[i] * csv[ii] + other * snv[ii]) : (e[i] * csv[ii] - other * snv[ii]); }
                        }
                    }
                    uint4 o0, o1;
                    o0.x = (unsigned)f2bf(e[0]) | ((unsigned)f2bf(e[1]) << 16); o0.y = (unsigned)f2bf(e[2]) | ((unsigned)f2bf(e[3]) << 16);
                    o0.z = (unsigned)f2bf(e[4]) | ((unsigned)f2bf(e[5]) << 16); o0.w = (unsigned)f2bf(e[6]) | ((unsigned)f2bf(e[7]) << 16);
                    o1.x = (unsigned)f2bf(e[8]) | ((unsigned)f2bf(e[9]) << 16); o1.y = (unsigned)f2bf(e[10]) | ((unsigned)f2bf(e[11]) << 16);
                    o1.z = (unsigned)f2bf(e[12]) | ((unsigned)f2bf(e[13]) << 16); o1.w = (unsigned)f2bf(e[14]) | ((unsigned)f2bf(e[15]) << 16);
                    *(uint4*)vp = o0; *(uint4*)(vp + 8) = o1;
                }
            } }
        }
    }
}

namespace att {
using bf16x8 = __attribute__((ext_vector_type(8))) short;
using s16x4  = __attribute__((ext_vector_type(4))) short;
using f32x16 = __attribute__((ext_vector_type(16))) float;
using u32x4  = __attribute__((ext_vector_type(4))) unsigned;
constexpr int KVBLK = 64;
constexpr float SCALE = 0.125f;
constexpr float THR = 8.f;
constexpr int SHM_V = KVBLK * 128 * 2, SHM_K = KVBLK * 128 * 2;
#define KSWZ(row, colB) ((row) * 256 + ((colB) ^ (((row) & 7) << 4)))
#define SBAR() __builtin_amdgcn_sched_barrier(0)
__device__ __forceinline__ int crow(int r, int hi) { return (r & 3) + 8 * (r >> 2) + 4 * hi; }
__device__ __forceinline__ unsigned cvtpk(float lo, float hi) { unsigned r; asm volatile("v_cvt_pk_bf16_f32 %0, %1, %2" : "=v"(r) : "v"(lo), "v"(hi)); return r; }
__device__ __forceinline__ void partialSM(f32x16& p0, f32x16& p1, float& m_reg, float& mn, float& alpha) {
  constexpr float C = SCALE * 1.4426950408889634f;
  float pmax = p0[0]; for (int r = 1; r < 16; ++r) pmax = fmaxf(pmax, p0[r]); for (int r = 0; r < 16; ++r) pmax = fmaxf(pmax, p1[r]);
  { auto rr = __builtin_amdgcn_permlane32_swap(__float_as_uint(pmax), __float_as_uint(pmax), false, false);
    pmax = fmaxf(__uint_as_float(rr[0]), __uint_as_float(rr[1])); }
  if (__builtin_expect(__all(pmax - m_reg <= THR / SCALE), 1)) { mn = m_reg; alpha = 1.f; }
  else { mn = fmaxf(m_reg, pmax); alpha = __builtin_amdgcn_exp2f((m_reg - mn) * C); m_reg = mn; }
  float mnC = -mn * C;
  for (int r = 0; r < 16; ++r) p0[r] = fmaf(p0[r], C, mnC); for (int r = 0; r < 16; ++r) p1[r] = fmaf(p1[r], C, mnC);
  for (int r = 0; r < 16; ++r) p0[r] = __builtin_amdgcn_exp2f(p0[r]);
}
__device__ __forceinline__ void finishSM(f32x16& p0, f32x16& p1, float alpha, float& l_reg, bf16x8& pa0, bf16x8& pa1, bf16x8& pa2, bf16x8& pa3) {
  for (int r = 0; r < 16; ++r) p1[r] = __builtin_amdgcn_exp2f(p1[r]);
  float ps = 0; for (int r = 0; r < 16; ++r) ps += p0[r]; for (int r = 0; r < 16; ++r) ps += p1[r];
  { auto rr = __builtin_amdgcn_permlane32_swap(__float_as_uint(ps), __float_as_uint(ps), false, false);
    ps = __uint_as_float(rr[0]) + __uint_as_float(rr[1]); }
  l_reg = l_reg * alpha + ps;
#define PK4(P, BASE, OUT) do { unsigned a0 = cvtpk(P[BASE + 0], P[BASE + 1]), a1 = cvtpk(P[BASE + 2], P[BASE + 3]);   \
    unsigned b0 = cvtpk(P[BASE + 4], P[BASE + 5]), b1 = cvtpk(P[BASE + 6], P[BASE + 7]);                              \
    auto r0 = __builtin_amdgcn_permlane32_swap(a0, b0, false, false); auto r1 = __builtin_amdgcn_permlane32_swap(a1, b1, false, false); \
    u32x4 w = {r0[0], r1[0], r0[1], r1[1]}; OUT = *reinterpret_cast<bf16x8*>(&w); } while (0)
  PK4(p0, 0, pa0); PK4(p0, 8, pa1); PK4(p1, 0, pa2); PK4(p1, 8, pa3);
#undef PK4
}
__device__ __forceinline__ void qkt(f32x16& p0, f32x16& p1, const char* Ks, const bf16x8* qr, int r32, int hi, int hfB) {
  p0 = f32x16{}; p1 = f32x16{};
#pragma unroll
  for (int d0 = 0; d0 < 4; ++d0) { int cb = hfB + (d0 * 16 + hi * 8) * 2;
    bf16x8 b0 = *reinterpret_cast<const bf16x8*>(Ks + KSWZ(r32, cb));
    bf16x8 b1 = *reinterpret_cast<const bf16x8*>(Ks + KSWZ(32 + r32, cb));
    p0 = __builtin_amdgcn_mfma_f32_32x32x16_bf16(b0, qr[d0], p0, 0, 0, 0);
    p1 = __builtin_amdgcn_mfma_f32_32x32x16_bf16(b1, qr[d0], p1, 0, 0, 0); }
}
__device__ __forceinline__ int v_st(int k, int c) { const int kk = (k & ~0xC) | ((k & 4) << 1) | ((k & 8) >> 1); return ((kk >> 3) * 4 + (c >> 5)) * 512 + ((kk & 7) * 32 + (c & 31)) * 2; }
__device__ __forceinline__ int v_rd_base(int lane) { return ((lane & 3) << 3) | (((lane >> 2) & 3) << 6) | (((lane >> 4) & 1) << 5) | (((lane >> 5) & 1) << 8); }
constexpr int v_rd_off(int d0, int ks, int half) { return d0 * 512 + ks * 4096 + half * 2048; }
template <int OFF> __device__ __forceinline__ s16x4 tr_read(int vb) {
  s16x4 r; asm volatile("ds_read_b64_tr_b16 %0, %1 offset:%2" : "=&v"(r) : "v"(vb), "i"(OFF) : "memory"); return r;
}
template <int D0> __device__ __forceinline__ void pv_one(f32x16& od, int vb, bf16x8 pa0, bf16x8 pa1, bf16x8 pa2, bf16x8 pa3) {
  const s16x4 l0 = tr_read<v_rd_off(D0, 0, 0)>(vb), h0 = tr_read<v_rd_off(D0, 0, 1)>(vb), l1 = tr_read<v_rd_off(D0, 1, 0)>(vb), h1 = tr_read<v_rd_off(D0, 1, 1)>(vb);
  const s16x4 l2 = tr_read<v_rd_off(D0, 2, 0)>(vb), h2 = tr_read<v_rd_off(D0, 2, 1)>(vb), l3 = tr_read<v_rd_off(D0, 3, 0)>(vb), h3 = tr_read<v_rd_off(D0, 3, 1)>(vb);
  asm volatile("s_waitcnt lgkmcnt(0)" ::: "memory"); SBAR();
#define PK(L, H) (bf16x8){L[0], L[1], L[2], L[3], H[0], H[1], H[2], H[3]}
  od = __builtin_amdgcn_mfma_f32_32x32x16_bf16(pa0, PK(l0, h0), od, 0, 0, 0);
  od = __builtin_amdgcn_mfma_f32_32x32x16_bf16(pa1, PK(l1, h1), od, 0, 0, 0);
  od = __builtin_amdgcn_mfma_f32_32x32x16_bf16(pa2, PK(l2, h2), od, 0, 0, 0);
  od = __builtin_amdgcn_mfma_f32_32x32x16_bf16(pa3, PK(l3, h3), od, 0, 0, 0);
#undef PK
}
__device__ __forceinline__ void pv_d0(f32x16* o, int vb, bf16x8 pa0, bf16x8 pa1, bf16x8 pa2, bf16x8 pa3) {
  pv_one<0>(o[0], vb, pa0, pa1, pa2, pa3); pv_one<1>(o[1], vb, pa0, pa1, pa2, pa3); pv_one<2>(o[2], vb, pa0, pa1, pa2, pa3); pv_one<3>(o[3], vb, pa0, pa1, pa2, pa3);
}
__device__ __forceinline__ void attn_unit(const bf16_t* __restrict__ PB, bf16_t* __restrict__ MIX, int qrow0, int h, int cbase, int lbase, int NT,
                                          float lam, float onorm, const float* __restrict__ gsub, char* lds, const int tid) {
  const int wid = tid >> 6, lane = tid & 63, r32 = lane & 31, hi = lane >> 5, rg = wid & 3, hf = wid >> 2, hfB = hf * 128;
  char* V_lds = lds; char* K_lds = lds + 2 * SHM_V;
  float* wsl = (float*)(lds + 2 * SHM_V + 2 * SHM_K) + wid * 64; float* li_l = wsl; float* al_l = wsl + 32;
  float m_reg = -1e30f, l_reg = 0; f32x16 o[4] = {}; bf16x8 qr[4];
  const bf16_t* Qw = PB + (size_t)(qrow0 + rg * 32 + r32) * DIN + OFF_Q + hf * 256 + h * 64 + hi * 8;
#pragma unroll
  for (int d0 = 0; d0 < 4; ++d0) qr[d0] = *reinterpret_cast<const bf16x8*>(Qw + d0 * 16);
  const int sr = tid >> 4, sc = (tid & 15) * 8, vst0 = v_st(sr, sc), vst1 = v_st(32 + sr, sc);
  const int kcol = OFF_K + h * 64 + (sc < 64 ? sc : 256 + sc - 64), vcol = OFF_V + h * 128 + sc;
  const int vb0 = (int)(uintptr_t)V_lds + v_rd_base(lane);
  struct { bf16x8 vs0, vs1, ks0, ks1; } sr_[2];
#define TROW(k0) ((k0) < CTXL ? (cbase + (k0)) : (lbase + (k0) - CTXL))
#define SLOAD(i, k0) do { const bf16_t* rp_ = PB + (size_t)(TROW(k0) + sr) * DIN; \
    sr_[i].vs0 = *reinterpret_cast<const bf16x8*>(rp_ + vcol); sr_[i].vs1 = *reinterpret_cast<const bf16x8*>(rp_ + (size_t)32 * DIN + vcol); \
    sr_[i].ks0 = *reinterpret_cast<const bf16x8*>(rp_ + kcol); sr_[i].ks1 = *reinterpret_cast<const bf16x8*>(rp_ + (size_t)32 * DIN + kcol); } while (0)
#define SWRITE(b, i) do { *(bf16x8*)(V_lds + (b) * SHM_V + vst0) = sr_[i].vs0;          \
    *(bf16x8*)(V_lds + (b) * SHM_V + vst1) = sr_[i].vs1; int kc = sc * 2;               \
    *(bf16x8*)(K_lds + (b) * SHM_K + KSWZ(sr, kc)) = sr_[i].ks0;                       \
    *(bf16x8*)(K_lds + (b) * SHM_K + KSWZ(32 + sr, kc)) = sr_[i].ks1; } while (0)
#define SWAIT() asm volatile("s_waitcnt vmcnt(4)" ::: "memory")
#define RESC(a) do { if (__any((a) < 1.f)) { if (hi == 0) al_l[r32] = (a); asm volatile("s_waitcnt lgkmcnt(0)" ::: "memory"); \
    for (int d = 0; d < 4; ++d) for (int r = 0; r < 16; ++r) o[d][r] *= al_l[crow(r, hi)]; } } while (0)
  f32x16 pA0, pA1, pB0, pB1; float mnA, mnB, alA, alB; bf16x8 pa0, pa1, pa2, pa3;
  constexpr int SE = 0, SO = 1;
  SLOAD(SE, 0); asm volatile("s_waitcnt vmcnt(0)" ::: "memory"); SWRITE(0, SE); __syncthreads();
  qkt(pA0, pA1, K_lds, qr, r32, hi, hfB); partialSM(pA0, pA1, m_reg, mnA, alA);
  SLOAD(SO, KVBLK); if (2 < NT) SLOAD(SE, 2 * KVBLK);
  SWAIT(); SWRITE(1, SO); __syncthreads();
  for (int j = 1; j + 1 < NT; j += 2) {
    SBAR(); qkt(pB0, pB1, K_lds + SHM_K, qr, r32, hi, hfB);
    finishSM(pA0, pA1, alA, l_reg, pa0, pa1, pa2, pa3); SBAR();
    SLOAD(SO, (j + 2) * KVBLK); SBAR();
    pv_d0(o, vb0, pa0, pa1, pa2, pa3); partialSM(pB0, pB1, m_reg, mnB, alB);
    __syncthreads(); SWAIT(); SWRITE(0, SE);
    RESC(alB); __syncthreads();
    SBAR(); qkt(pA0, pA1, K_lds, qr, r32, hi, hfB);
    finishSM(pB0, pB1, alB, l_reg, pa0, pa1, pa2, pa3); SBAR();
    if (j + 3 < NT) SLOAD(SE, (j + 3) * KVBLK); SBAR();
    pv_d0(o, vb0 + (int)SHM_V, pa0, pa1, pa2, pa3); partialSM(pA0, pA1, m_reg, mnA, alA);
    __syncthreads(); SWAIT(); SWRITE(1, SO);
    RESC(alA); __syncthreads();
  }
  SBAR(); qkt(pB0, pB1, K_lds + SHM_K, qr, r32, hi, hfB);
  finishSM(pA0, pA1, alA, l_reg, pa0, pa1, pa2, pa3); SBAR();
  pv_d0(o, vb0, pa0, pa1, pa2, pa3); partialSM(pB0, pB1, m_reg, mnB, alB);
  __syncthreads(); RESC(alB);
  finishSM(pB0, pB1, alB, l_reg, pa0, pa1, pa2, pa3); SBAR();
  pv_d0(o, vb0 + (int)SHM_V, pa0, pa1, pa2, pa3);
  if (hi == 0) li_l[r32] = l_reg; asm volatile("s_waitcnt lgkmcnt(0)" ::: "memory");
  float rli[16];
#pragma unroll
  for (int r = 0; r < 16; ++r) rli[r] = __builtin_amdgcn_rcpf(li_l[crow(r, hi)]);
  __syncthreads();
  float* X = (float*)lds + rg * 4096;
  if (hf == 1) {
#pragma unroll
    for (int r = 0; r < 16; ++r)
#pragma unroll
      for (int d0 = 0; d0 < 4; ++d0) X[crow(r, hi) * 128 + d0 * 32 + r32] = o[d0][r] * rli[r] * lam;
  }
  __syncthreads();
  if (hf == 0) {
    float g4[4];
#pragma unroll
    for (int d0 = 0; d0 < 4; ++d0) g4[d0] = gsub[d0 * 32 + r32] * onorm;
    bf16_t* Ow = MIX + (size_t)(qrow0 + rg * 32) * D + 512 + h * 128 + r32;
#pragma unroll
    for (int r = 0; r < 16; ++r) {
      float v[4]; float ss = 0.f;
#pragma unroll
      for (int d0 = 0; d0 < 4; ++d0) { v[d0] = o[d0][r] * rli[r] - X[crow(r, hi) * 128 + d0 * 32 + r32]; ss += v[d0] * v[d0]; }
      ss += __shfl_xor(ss, 1); ss += __shfl_xor(ss, 2); ss += __shfl_xor(ss, 4); ss += __shfl_xor(ss, 8); ss += __shfl_xor(ss, 16);
      const float inv = rsqrtf(ss * (1.0f / 128.0f) + EPS);
#pragma unroll
      for (int d0 = 0; d0 < 4; ++d0) Ow[(size_t)crow(r, hi) * D + d0 * 32] = f2bf(v[d0] * inv * g4[d0]);
    }
  }
  __syncthreads();
#undef TROW
#undef SLOAD
#undef SWRITE
#undef SWAIT
#undef RESC
}
#undef KSWZ
#undef SBAR
}

__device__ __forceinline__ void phase_attn_fast(KP p, int l, char* lds) {
  const int tid = opaque_tid();
  const bf16_t* PB = (const bf16_t*)(p->ws + WS_PB); bf16_t* MIX = (bf16_t*)(p->ws + WS_MIX);
  const float lam = ((const float*)(p->ws + WS_MOD))[2 * 9 * 6144 + l];
  const float lam_init = 0.8f - 0.6f * expf(-0.3f * (float)l);
  const float* gsub = p->in[I_GSUB] + l * 128;
  const int NU = 512 + (l == 0 ? 64 : 0);
  for (int L = blockIdx.x; L < NU; L += gridDim.x) {
    if (L < 512) {
      const int xcd = L & 7, j = (L >> 3) & 31, rd = L >> 8, pair = rd * 16 + xcd * 2 + (j >> 4), qb = j & 15, b = pair >> 2, h = pair & 3;
      att::attn_unit(PB, MIX, b * SEQ + qb * 128, h, RL + b * CTXL, b * SEQ, (CTXL + SEQ) / 64, lam, 1.0f - lam_init, gsub, lds, tid);
    } else {
      const int cu = L - 512, b = cu >> 3, h = (cu >> 1) & 3, qb = cu & 1;
      att::attn_unit(PB, MIX, RL + b * CTXL + qb * 128, h, RL + b * CTXL, 0, CTXL / 64, lam, 1.0f - lam_init, gsub, lds, tid);
    }
  }
}
__device__ __forceinline__ void phase_outproj(KP p, int l, LAS float* sm) {
    const int tid = opaque_tid(), ty = tid >> 4, tx = tid & 15;
    LAS int* rowidx = (LAS int*)(sm + 16 * 132 + 2 * 16 * 128);
    const bf16_t* MIX = (const bf16_t*)(p->ws + WS_MIX);
    const float* W = p->in[I_WOUT] + (size_t)l * D * D;
    const float* MOD = (const float*)(p->ws + WS_MOD) + (size_t)l * 9 * 6144;
    const int nMt = (l == 0 ? RT : RL) / 128, nNt = D / 128;
    for (int u = blockIdx.x; u < nMt * nNt; u += gridDim.x) {
        const int mt = u / nNt, nt = u % nNt;
        if (tid < 128) rowidx[tid] = mt * 128 + tid;
        __syncthreads();
        float acc[4][8], acc2[4][8];
        sgemm_tile<true, false>(sm, MIX, D, rowidx, W, nullptr, D, nt * 128, D, acc, acc2, tid);
#pragma unroll
        for (int i = 0; i < 4; ++i) { const int r = mt * 128 + ty * 4 + i; const int bb = row_bb(r); const float* xs = xsrc_row(p, l, r); float* xw = xw_row(p, r);
#pragma unroll
            for (int j = 0; j < 8; ++j) { const int c = nt * 128 + tx * 8 + j; xw[c] = xs[c] + MOD[bb * 6144 + 2048 + c] * acc[i][j]; } }
    }
}

__device__ __forceinline__ void phase_norm2_router(KP p, int l, LAS float* sm) {
    const int tid = opaque_tid(), lane = tid & 63, wave = tid >> 6;
    const int gw = blockIdx.x * NWAVES + wave, NGW = gridDim.x * NWAVES;
    const float* MOD = (const float*)(p->ws + WS_MOD) + (size_t)l * 9 * 6144;
    bf16_t* HB = (bf16_t*)(p->ws + WS_HB);
    unsigned* counts = (unsigned*)(p->ws + WS_CTL) + CW_CNT + l * 64;
    uint2* LIST = (uint2*)(p->ws + WS_LIST);
    const float* WR = p->in[I_WROUTER] + (size_t)l * D * NE;
    const float brt = p->in[I_BROUTER][l * NE + lane];
    LAS float* hs = sm + wave * 1024;
    const int nrows = (l == 0) ? RT : RL;
    for (int r = gw; r < nrows; r += NGW) {
        const int bb = row_bb(r); float hv[16];
        norm_row(xw_row(p, r), p->in[I_GN2] + l * D, MOD + bb * 6144 + 4096, MOD + bb * 6144 + 3072, HB + (size_t)r * D, lane, hv);
#pragma unroll
        for (int j = 0; j < 4; ++j) { *(LAS f32x4*)(hs + lane * 4 + 256 * j) = (f32x4){hv[4 * j], hv[4 * j + 1], hv[4 * j + 2], hv[4 * j + 3]}; }
        asm volatile("s_waitcnt lgkmcnt(0)" ::: "memory");
        float lg0 = 0.f, lg1 = 0.f, lg2 = 0.f, lg3 = 0.f;
        for (int k = 0; k < D; k += 4) {
            lg0 = fmaf(hs[k + 0], WR[(size_t)(k + 0) * NE + lane], lg0); lg1 = fmaf(hs[k + 1], WR[(size_t)(k + 1) * NE + lane], lg1);
            lg2 = fmaf(hs[k + 2], WR[(size_t)(k + 2) * NE + lane], lg2); lg3 = fmaf(hs[k + 3], WR[(size_t)(k + 3) * NE + lane], lg3);
        }
        const float logit = (lg0 + lg1) + (lg2 + lg3);
        const float score = 1.0f / (1.0f + expf(-logit));
        float key = score + brt;
        float ssum = 0.f; int myrank = -1;
#pragma unroll 1
        for (int k = 0; k < TOPK; ++k) {
            const float mx = wave_max(key);
            const unsigned long long bal = __ballot(key == mx);
            const int win = __ffsll((long long)bal) - 1;
            ssum += __shfl(score, win);
            if (lane == win) { myrank = k; key = -1e30f; }
        }
        if (myrank >= 0) {
            const float gate = score / ssum * 2.5f;
            const unsigned pos = atomicAdd(&counts[lane], 1u);
            uint2 e; e.x = (unsigned)(r * 8 + myrank); e.y = __float_as_uint(gate);
            LIST[(size_t)lane * RT + pos] = e;
        }
    }
}


namespace pg8 {
typedef short bf16x8 __attribute__((ext_vector_type(8)));
typedef unsigned u32x4 __attribute__((ext_vector_type(4)));
typedef float f32x2 __attribute__((ext_vector_type(2)));
typedef int i32x8 __attribute__((ext_vector_type(8)));
constexpr int FP8_WSCALE = 123;
constexpr int BM = 256, BK = 64, HALF = 128, HTB = HALF * BK * 2, STAGE_BYTES = 8 * HTB, NXCD = 8, WGM = 8, AUX_OFF = 132096;
__device__ __forceinline__ int lds_byte(int r, int c) { const int st = (r >> 4) * 2 + (c >> 5), rr = r & 15, cc = c & 31, ob = rr * 64 + cc * 2; return st * 1024 + (ob ^ (((ob >> 9) & 1) << 5)); }
__device__ __forceinline__ void stage_rc(int b, int& R, int& C) { const int st = b / 1024, sb = b % 1024, swz = sb ^ (((sb >> 9) & 1) << 5); R = (st >> 1) * 16 + swz / 64; C = (st & 1) * 32 + (swz % 64) / 2; }
__device__ __forceinline__ int perm32(int rho) { const int n = rho >> 4, i = rho & 15; return 8 * (i >> 2) + 4 * n + (i & 3); }
struct GUnit { const char* Bp; int e, m0, pn, cnt, sb; };
__device__ __forceinline__ unsigned cvt_pk_bf16(float lo, float hi) { unsigned r; asm volatile("v_cvt_pk_bf16_f32 %0, %1, %2" : "=v"(r) : "v"(lo), "v"(hi)); return r; }
__device__ __forceinline__ f32x2 gelu_pk(f32x2 v) {
    const f32x2 av = __builtin_elementwise_abs(v), d = av * 0.2316418882f + 1.0f;
    f32x2 t; t.x = __builtin_amdgcn_rcpf(d.x); t.y = __builtin_amdgcn_rcpf(d.y);
    f32x2 q = t * 0.5307027145f + (-0.7265760135f); q = q * t + 0.7107068705f; q = q * t + (-0.142248368f); q = q * t + 0.127414796f; q = q * t;
    const f32x2 s = (v * v) * (-0.72134752044f);
    f32x2 e; e.x = __builtin_amdgcn_exp2f(s.x); e.y = __builtin_amdgcn_exp2f(s.y);
    const f32x2 m = v * (q * e), r = v - m;
    f32x2 o; o.x = v.x < 0.f ? m.x : r.x; o.y = v.y < 0.f ? m.y : r.y; return o;
}
__device__ __forceinline__ int xcd_remap(int L, int n) { const int q = n / NXCD, r = n % NXCD, xcd = L % NXCD, off = L / NXCD; return (xcd < r ? xcd * (q + 1) : r * (q + 1) + (xcd - r) * q) + off; }

template <bool ALIGN_EPI, bool SP2, bool AUX, bool FP8, int ASCALE, class Sched, class Epi>
__device__ __forceinline__ void gemm_phase(LAS unsigned char* lds, const char* Abase, const int K, const Sched& S, const Epi& E, const int tid) {
    const int wid = __builtin_amdgcn_readfirstlane(tid >> 6), lane = tid & 63, wr = wid >> 2, wc = wid & 3, fr = lane & 15, fq = lane >> 4;
    const int nt = K / BK;
    int Rs[2], Cs[2]; unsigned voffB[2];
#pragma unroll
    for (int i = 0; i < 2; ++i) { int R, C; stage_rc(tid * 16 + i * 8192, R, C); Rs[i] = R; Cs[i] = C; const int Rb = 64 * (R >> 5) + perm32(R & 31); voffB[i] = (unsigned)(Rb * K + C) * 2u; }
    const size_t kstep = (size_t)(BK * 2);
    const size_t hstep = (size_t)32 * K * 2;
    const unsigned ldsw = (unsigned)wid * 1024u;
    const int aoff = lds_byte(wr * 64 + fr, fq * 8), boff = lds_byte(wc * 32 + fr, fq * 8);
    const int aoff8 = lds_byte(wr * 64 + fr, 32 * (fq >> 1) + 16 * (fq & 1)), boff8 = lds_byte(wc * 32 + fr, 32 * (fq >> 1) + 16 * (fq & 1));
#define PG8_SA(b, h) (((b) * 2 + (h)) * HTB)
#define PG8_SB(b, h) ((4 + (b) * 2 + (h)) * HTB)
#define PG8_STAGE_B(bufoff, gbase) do { _Pragma("unroll") for (int _i = 0; _i < 2; ++_i) \
        __builtin_amdgcn_global_load_lds((const unsigned*)((const char*)(gbase) + voffB[_i]), (LAS unsigned*)(lds + (bufoff) + ldsw + _i * 8192), 16, 0, 0); } while (0)
#define PG8_STAGE_A(bufoff, OFFS, h, koff) do { _Pragma("unroll") for (int _i = 0; _i < 2; ++_i) \
        __builtin_amdgcn_global_load_lds((const unsigned*)(Abase + (size_t)(OFFS)[h][_i] + (koff)), (LAS unsigned*)(lds + (bufoff) + ldsw + _i * 8192), 16, 0, 0); } while (0)
#define PG8_LDA(dst, b, h) do { if constexpr (FP8) { _Pragma("unroll") for (int m = 0; m < 4; ++m) { const u32x4 lo_ = *(const LAS u32x4*)(lds + PG8_SA(b, h) + aoff8 + m * 2048), hi_ = *(const LAS u32x4*)(lds + PG8_SA(b, h) + aoff8 + m * 2048 + 16); \
            dst##8[m] = (i32x8){(int)lo_.x, (int)lo_.y, (int)lo_.z, (int)lo_.w, (int)hi_.x, (int)hi_.y, (int)hi_.z, (int)hi_.w}; } } \
        else { _Pragma("unroll") for (int m = 0; m < 4; ++m) _Pragma("unroll") for (int k = 0; k < 2; ++k) dst[m][k] = *(const LAS bf16x8*)(lds + PG8_SA(b, h) + aoff + m * 2048 + k * 1024); } } while (0)
#define PG8_LDB(dst, b, h) do { if constexpr (FP8) { _Pragma("unroll") for (int n = 0; n < 2; ++n) { const u32x4 lo_ = *(const LAS u32x4*)(lds + PG8_SB(b, h) + boff8 + n * 2048), hi_ = *(const LAS u32x4*)(lds + PG8_SB(b, h) + boff8 + n * 2048 + 16); \
            dst##8[n] = (i32x8){(int)lo_.x, (int)lo_.y, (int)lo_.z, (int)lo_.w, (int)hi_.x, (int)hi_.y, (int)hi_.z, (int)hi_.w}; } } \
        else { _Pragma("unroll") for (int n = 0; n < 2; ++n) _Pragma("unroll") for (int k = 0; k < 2; ++k) dst[n][k] = *(const LAS bf16x8*)(lds + PG8_SB(b, h) + boff + n * 2048 + k * 1024); } } while (0)
#define PG8_MMA(ai, bj, At, Bt) do { __builtin_amdgcn_s_setprio(1); if constexpr (FP8) { _Pragma("unroll") for (int m = 0; m < 4; ++m) _Pragma("unroll") for (int n = 0; n < 2; ++n) \
            acc[ai][bj][m][n] = __builtin_amdgcn_mfma_scale_f32_16x16x128_f8f6f4(Bt##8[n], At##8[m], acc[ai][bj][m][n], 0, 0, 0, FP8_WSCALE, 0, ASCALE); } \
        else { _Pragma("unroll") for (int m = 0; m < 4; ++m) _Pragma("unroll") for (int n = 0; n < 2; ++n) _Pragma("unroll") for (int k = 0; k < 2; ++k) \
        acc[ai][bj][m][n] = __builtin_amdgcn_mfma_f32_16x16x32_bf16(Bt[n][k], At[m][k], acc[ai][bj][m][n], 0, 0, 0); } __builtin_amdgcn_s_setprio(0); } while (0)
#define PG8_WAIT_V(n) asm volatile("s_waitcnt vmcnt(" #n ")" ::: "memory")
#define PG8_WAIT_L(n) asm volatile("s_waitcnt lgkmcnt(" #n ")" ::: "memory")
#define PG8_BAR __builtin_amdgcn_s_barrier()
#define PG8_SCHED __builtin_amdgcn_sched_barrier(0)
    LAS unsigned* auxtab = (LAS unsigned*)(lds + AUX_OFF);
#define PG8_AUX(u, sel) do { if constexpr (AUX) { if (wid < 4) __builtin_amdgcn_global_load_lds((const unsigned*)S.aux_src(u, wid * 64 + lane), auxtab + (sel) * 256 + wid * 64, 4, 0, 0); } } while (0)
    GUnit cur, nxt; int ui = 0;
    if (!S.next(0, cur)) return;
    f32x4 acc[2][2][4][2];
#pragma unroll
    for (int a = 0; a < 2; ++a)
#pragma unroll
        for (int b = 0; b < 2; ++b)
#pragma unroll
            for (int m = 0; m < 4; ++m)
#pragma unroll
                for (int n = 0; n < 2; ++n) acc[a][b][m][n] = (f32x4){0.f, 0.f, 0.f, 0.f};
    bf16x8 At[4][2], B0[2][2], B1[2][2];
    i32x8 At8[4], B08[2], B18[2];
    unsigned cO[2][2];
    S.a_offs(cur, Rs, Cs, cO);
    PG8_AUX(cur, 0);
    const char* cB = cur.Bp;
    if constexpr (SP2) {
        PG8_STAGE_B(PG8_SB(0, 0), cB); PG8_STAGE_B(PG8_SB(0, 1), cB + hstep); PG8_STAGE_A(PG8_SA(0, 0), cO, 0, 0); PG8_STAGE_A(PG8_SA(0, 1), cO, 1, 0);
        if (wr == 1) PG8_BAR;
        PG8_WAIT_V(2); PG8_BAR;
        PG8_STAGE_B(PG8_SB(1, 0), cB + kstep); PG8_STAGE_A(PG8_SA(1, 0), cO, 0, kstep); PG8_STAGE_B(PG8_SB(1, 1), cB + hstep + kstep);
        PG8_WAIT_V(6); PG8_BAR;
    } else {
    PG8_STAGE_B(PG8_SB(0, 0), cB); PG8_STAGE_A(PG8_SA(0, 0), cO, 0, 0); PG8_STAGE_B(PG8_SB(0, 1), cB + hstep); PG8_STAGE_A(PG8_SA(0, 1), cO, 1, 0);
    if (wr == 1) PG8_BAR;
    PG8_WAIT_V(4); PG8_BAR;
    PG8_STAGE_B(PG8_SB(1, 0), cB + kstep); PG8_STAGE_A(PG8_SA(1, 0), cO, 0, kstep); PG8_STAGE_B(PG8_SB(1, 1), cB + hstep + kstep);
    PG8_WAIT_V(6); PG8_BAR;
    }
    for (;;) {
        const bool has_next = S.next(ui + 1, nxt);
        const char* nB = has_next ? nxt.Bp : cB;
#pragma unroll 1
        for (int t = 0; t < nt; t += 2) {
            const bool last = (t == nt - 2);
            const size_t k1 = (size_t)(t + 1) * kstep, k2 = last ? (size_t)0 : (size_t)(t + 2) * kstep, k3 = k2 + kstep;
            const char* b2 = last ? nB : cB + (size_t)(t + 2) * kstep; const char* b3 = b2 + kstep;
            if constexpr (SP2) {
            PG8_LDB(B0, 0, 0); PG8_LDB(B1, 0, 1); PG8_SCHED; PG8_LDA(At, 0, 0); PG8_STAGE_A(PG8_SA(1, 1), cO, 1, k1);
            PG8_WAIT_V(8); PG8_WAIT_L(0); PG8_BAR; PG8_MMA(0, 0, At, B0); PG8_MMA(0, 1, At, B1); PG8_BAR; PG8_SCHED;
            if (last && has_next) { S.a_offs(nxt, Rs, Cs, cO); PG8_AUX(nxt, (ui + 1) & 1); }
            PG8_LDA(At, 0, 1); PG8_STAGE_B(PG8_SB(0, 0), b2); PG8_STAGE_B(PG8_SB(0, 1), b2 + hstep); PG8_STAGE_A(PG8_SA(0, 0), cO, 0, k2);
            PG8_WAIT_V(8); PG8_WAIT_L(0); PG8_BAR; PG8_MMA(1, 0, At, B0); PG8_MMA(1, 1, At, B1); PG8_BAR; PG8_SCHED;
            PG8_LDB(B0, 1, 0); PG8_LDB(B1, 1, 1); PG8_SCHED; PG8_LDA(At, 1, 0); PG8_STAGE_A(PG8_SA(0, 1), cO, 1, k2);
            PG8_WAIT_V(8); PG8_WAIT_L(0); PG8_BAR; PG8_MMA(0, 0, At, B0); PG8_MMA(0, 1, At, B1); PG8_BAR; PG8_SCHED;
            PG8_LDA(At, 1, 1); PG8_STAGE_B(PG8_SB(1, 0), b3); PG8_STAGE_B(PG8_SB(1, 1), b3 + hstep); PG8_STAGE_A(PG8_SA(1, 0), cO, 0, k3);
            PG8_WAIT_V(8); PG8_WAIT_L(0); PG8_BAR; PG8_MMA(1, 0, At, B0); PG8_MMA(1, 1, At, B1); PG8_BAR; PG8_SCHED;
            } else {
            PG8_LDB(B0, 0, 0); PG8_SCHED; PG8_LDA(At, 0, 0); PG8_STAGE_A(PG8_SA(1, 1), cO, 1, k1);
            PG8_WAIT_L(8); PG8_BAR; PG8_WAIT_L(0); PG8_MMA(0, 0, At, B0); PG8_BAR; PG8_SCHED;
            if (last && has_next) { S.a_offs(nxt, Rs, Cs, cO); PG8_AUX(nxt, (ui + 1) & 1); }
            PG8_LDB(B1, 0, 1); PG8_STAGE_B(PG8_SB(0, 0), b2);
            PG8_BAR; PG8_WAIT_L(0); PG8_MMA(0, 1, At, B1); PG8_BAR;
            PG8_LDA(At, 0, 1); PG8_STAGE_A(PG8_SA(0, 0), cO, 0, k2);
            PG8_BAR; PG8_WAIT_L(0); PG8_MMA(1, 0, At, B0); PG8_BAR; PG8_SCHED;
            PG8_STAGE_B(PG8_SB(0, 1), b2 + hstep);
            PG8_WAIT_V(6); PG8_BAR; PG8_MMA(1, 1, At, B1); PG8_BAR;
            PG8_LDB(B0, 1, 0); PG8_SCHED; PG8_LDA(At, 1, 0); PG8_STAGE_A(PG8_SA(0, 1), cO, 1, k2);
            PG8_WAIT_L(8); PG8_BAR; PG8_WAIT_L(0); PG8_MMA(0, 0, At, B0); PG8_BAR; PG8_SCHED;
            PG8_LDB(B1, 1, 1); PG8_STAGE_B(PG8_SB(1, 0), b3);
            PG8_BAR; PG8_WAIT_L(0); PG8_MMA(0, 1, At, B1); PG8_BAR;
            PG8_LDA(At, 1, 1); PG8_STAGE_A(PG8_SA(1, 0), cO, 0, k3);
            PG8_BAR; PG8_WAIT_L(0); PG8_MMA(1, 0, At, B0); PG8_BAR; PG8_SCHED;
            PG8_STAGE_B(PG8_SB(1, 1), b3 + hstep);
            PG8_WAIT_V(6); PG8_BAR; PG8_MMA(1, 1, At, B1); PG8_BAR;
            }
        }
        if constexpr (ALIGN_EPI) { if (wr == 0) PG8_BAR; }
        E(acc, cur, wr, wc, fr, fq, auxtab + (ui & 1) * 256);
        if (!has_next) break;
#pragma unroll
        for (int a = 0; a < 2; ++a)
#pragma unroll
            for (int b = 0; b < 2; ++b)
#pragma unroll
                for (int m = 0; m < 4; ++m)
#pragma unroll
                    for (int n = 0; n < 2; ++n) acc[a][b][m][n] = (f32x4){0.f, 0.f, 0.f, 0.f};
        cur = nxt; cB = nB; ++ui;
        if constexpr (ALIGN_EPI) { if (wr == 1) PG8_BAR; }
    }
    PG8_WAIT_V(0);
    if constexpr (!ALIGN_EPI) { if (wr == 0) PG8_BAR; }
    PG8_BAR;
#undef PG8_SA
#undef PG8_SB
#undef PG8_STAGE_A
#undef PG8_STAGE_B
#undef PG8_LDA
#undef PG8_LDB
#undef PG8_MMA
#undef PG8_WAIT_V
#undef PG8_WAIT_L
#undef PG8_BAR
#undef PG8_SCHED
#undef PG8_AUX
}

struct SchedDense {
    int nM, nN, nwg, G, c, K, nExtra, xpm0, xpn0, xn; const char* Bt;
    __device__ __forceinline__ bool next(int i, GUnit& u) const {
        const int L = i * G + c; if (L >= nwg + nExtra) return false;
        int pm, pn;
        if (L < nwg) { const int wgid = xcd_remap(L, nwg); const int nig = WGM * nN, gid = wgid / nig, fm = gid * WGM, gsz = (nM - fm) < WGM ? (nM - fm) : WGM; pm = fm + ((wgid % nig) % gsz); pn = (wgid % nig) / gsz; }
        else { const int j = L - nwg; pm = xpm0 + j / xn; pn = xpn0 + j % xn; }
        u.Bp = Bt + (size_t)pn * 256 * K * 2; u.e = -1; u.m0 = pm * 256; u.pn = pn; u.cnt = 0x7fffffff; u.sb = 0; return true;
    }
    __device__ __forceinline__ void a_offs(const GUnit& u, const int (&Rs)[2], const int (&Cs)[2], unsigned (&o)[2][2]) const {
#pragma unroll
        for (int h = 0; h < 2; ++h)
#pragma unroll
            for (int i = 0; i < 2; ++i) o[h][i] = (unsigned)((u.m0 + Rs[i] + 128 * h) * K + Cs[i]) * 2u;
    }
    __device__ __forceinline__ const void* aux_src(const GUnit&, int) const { return nullptr; }
};
template <bool UP> struct SchedMoe {
    const LAS int* tstart; const LAS int* sbase; const LAS int* cntv; int NPN, G, c, nU, K; const char* Wbase; const uint2* LIST;
    __device__ __forceinline__ bool next(int i, GUnit& u) const {
        const int L = i * G + c; if (L >= nU) return false;
        const int uu = xcd_remap(L, nU), t = uu / NPN, pn = uu % NPN;
        const int lane = __builtin_amdgcn_mbcnt_hi(~0u, __builtin_amdgcn_mbcnt_lo(~0u, 0u));
        const int e = __builtin_popcountll(__ballot(tstart[lane + 1] <= t));
        u.e = e; u.m0 = (t - tstart[e]) * 256; u.pn = pn; u.cnt = cntv[e]; u.sb = sbase[e];
        u.Bp = Wbase + (size_t)e * WEXP_STRIDE + (size_t)pn * 256 * K * 2; return true;
    }
    __device__ __forceinline__ void a_offs(const GUnit& u, const int (&Rs)[2], const int (&Cs)[2], unsigned (&o)[2][2]) const {
#pragma unroll
        for (int h = 0; h < 2; ++h)
#pragma unroll
            for (int i = 0; i < 2; ++i) {
                const int slot = u.m0 + Rs[i] + 128 * h; int row;
                if (UP) { row = 0; if (slot < u.cnt) row = u.e < 64 ? (int)(LIST[(size_t)u.e * RT + slot].x >> 3) : slot; }
                else row = u.sb + slot;
                o[h][i] = (unsigned)(row * K + Cs[i]) * 2u;
            }
    }
    __device__ __forceinline__ const void* aux_src(const GUnit& u, int s) const { return (const unsigned*)(LIST + (size_t)(u.e < 64 ? u.e : 0) * RT + u.m0 + s) + (UP ? 1 : 0); }
};
}

struct EpiInproj { bf16_t* PB;
    __device__ __forceinline__ void operator()(const f32x4 (&acc)[2][2][4][2], const pg8::GUnit& u, int wr, int wc, int fr, int fq, const LAS unsigned* aux) const {
        const int row0 = u.m0 + wr * 64 + fr, col0 = u.pn * 256 + wc * 64 + 8 * fq; const bool act = u.pn < 2;
#pragma unroll
        for (int ai = 0; ai < 2; ++ai)
#pragma unroll
            for (int m = 0; m < 4; ++m) { bf16_t* rowp = PB + (size_t)(row0 + ai * 128 + m * 16) * DIN + col0;
#pragma unroll
                for (int bj = 0; bj < 2; ++bj) { f32x4 v0 = acc[ai][bj][m][0], v1 = acc[ai][bj][m][1];
                    if (act) { const pg8::f32x2 a = pg8::gelu_pk((pg8::f32x2){v0[0], v0[1]}), b = pg8::gelu_pk((pg8::f32x2){v0[2], v0[3]}), c = pg8::gelu_pk((pg8::f32x2){v1[0], v1[1]}), d = pg8::gelu_pk((pg8::f32x2){v1[2], v1[3]});
                        v0 = (f32x4){a.x, a.y, b.x, b.y}; v1 = (f32x4){c.x, c.y, d.x, d.y}; }
                    pg8::u32x4 w; w.x = pg8::cvt_pk_bf16(v0[0], v0[1]); w.y = pg8::cvt_pk_bf16(v0[2], v0[3]); w.z = pg8::cvt_pk_bf16(v1[0], v1[1]); w.w = pg8::cvt_pk_bf16(v1[2], v1[3]);
                    *(pg8::u32x4*)(rowp + bj * 32) = w; } }
    }
};
struct EpiOutproj { bf16_t* Y;
    __device__ __forceinline__ void operator()(const f32x4 (&acc)[2][2][4][2], const pg8::GUnit& u, int wr, int wc, int fr, int fq, const LAS unsigned* aux) const {
        const int row0 = u.m0 + wr * 64 + fr, col0 = u.pn * 256 + wc * 64 + 8 * fq;
#pragma unroll
        for (int ai = 0; ai < 2; ++ai)
#pragma unroll
            for (int m = 0; m < 4; ++m) { bf16_t* rowp = Y + (size_t)(row0 + ai * 128 + m * 16) * D + col0;
#pragma unroll
                for (int bj = 0; bj < 2; ++bj) { const f32x4 v0 = acc[ai][bj][m][0], v1 = acc[ai][bj][m][1];
                    pg8::u32x4 w; w.x = pg8::cvt_pk_bf16(v0[0], v0[1]); w.y = pg8::cvt_pk_bf16(v0[2], v0[3]); w.z = pg8::cvt_pk_bf16(v1[0], v1[1]); w.w = pg8::cvt_pk_bf16(v1[2], v1[3]);
                    *(pg8::u32x4*)(rowp + bj * 32) = w; } }
    }
};
struct EpiMoeUp { const uint2* LIST; bf16_t* HID;
    __device__ __forceinline__ void operator()(const f32x4 (&acc)[2][2][4][2], const pg8::GUnit& u, int wr, int wc, int fr, int fq, const LAS unsigned* aux) const {
        float gt[2][4];
#pragma unroll
        for (int ai = 0; ai < 2; ++ai)
#pragma unroll
            for (int m = 0; m < 4; ++m) gt[ai][m] = __uint_as_float(aux[ai * 128 + wr * 64 + m * 16 + fr]);
#pragma unroll
        for (int ai = 0; ai < 2; ++ai)
#pragma unroll
            for (int m = 0; m < 4; ++m) { const int slot = u.m0 + ai * 128 + wr * 64 + m * 16 + fr;
                const float gtv = u.e < 64 ? gt[ai][m] : 1.0f;
                float h[8];
#pragma unroll
                for (int n = 0; n < 2; ++n)
#pragma unroll
                    for (int j = 0; j < 4; ++j) { const float gv = acc[ai][0][m][n][j], uv = acc[ai][1][m][n][j]; h[n * 4 + j] = gv * __builtin_amdgcn_rcpf(1.0f + __expf(-gv)) * uv * gtv; }
                int w0 = 0, w1 = 0;
                w0 = __builtin_amdgcn_cvt_pk_fp8_f32(h[0] * 16.0f, h[1] * 16.0f, w0, false); w0 = __builtin_amdgcn_cvt_pk_fp8_f32(h[2] * 16.0f, h[3] * 16.0f, w0, true);
                w1 = __builtin_amdgcn_cvt_pk_fp8_f32(h[4] * 16.0f, h[5] * 16.0f, w1, false); w1 = __builtin_amdgcn_cvt_pk_fp8_f32(h[6] * 16.0f, h[7] * 16.0f, w1, true);
                uint2 w; w.x = (unsigned)w0; w.y = (unsigned)w1;
                if (slot < u.cnt) *(uint2*)((unsigned char*)HID + (size_t)(u.sb + slot) * DE + u.pn * 128 + wc * 32 + 8 * fq) = w; }
    }
};
struct EpiMoeDown { const uint2* LIST; bf16_t* ROWS; KP p; const float* g2;
    __device__ __forceinline__ void operator()(const f32x4 (&acc)[2][2][4][2], const pg8::GUnit& u, int wr, int wc, int fr, int fq, const LAS unsigned* aux) const {
        const int col0 = u.pn * 256 + wc * 64 + 8 * fq;
        if (u.e < 64) {
            unsigned pr[2][4];
#pragma unroll
            for (int ai = 0; ai < 2; ++ai)
#pragma unroll
                for (int m = 0; m < 4; ++m) pr[ai][m] = aux[ai * 128 + wr * 64 + m * 16 + fr];
#pragma unroll
            for (int ai = 0; ai < 2; ++ai)
#pragma unroll
                for (int m = 0; m < 4; ++m) { const int slot = u.m0 + ai * 128 + wr * 64 + m * 16 + fr;
                    if (slot < u.cnt) { unsigned char* dst = (unsigned char*)ROWS + (size_t)pr[ai][m] * D + col0;
#pragma unroll
                        for (int bj = 0; bj < 2; ++bj) { const f32x4 v0 = acc[ai][bj][m][0] * ROWS_SCALE, v1 = acc[ai][bj][m][1] * ROWS_SCALE;
                            int w0 = 0, w1 = 0;
                            w0 = __builtin_amdgcn_cvt_pk_fp8_f32(v0[0], v0[1], w0, false); w0 = __builtin_amdgcn_cvt_pk_fp8_f32(v0[2], v0[3], w0, true);
                            w1 = __builtin_amdgcn_cvt_pk_fp8_f32(v1[0], v1[1], w1, false); w1 = __builtin_amdgcn_cvt_pk_fp8_f32(v1[2], v1[3], w1, true);
                            uint2 w; w.x = (unsigned)w0; w.y = (unsigned)w1;
                            *(uint2*)(dst + bj * 32) = w; } } }
        } else {
            const int bb = u.m0 < RL ? u.m0 / SEQ : 8;
            f32x4 g[2][2];
#pragma unroll
            for (int bj = 0; bj < 2; ++bj)
#pragma unroll
                for (int n = 0; n < 2; ++n) g[bj][n] = *(const f32x4*)(g2 + bb * 6144 + col0 + bj * 32 + 4 * n);
#pragma unroll
            for (int ai = 0; ai < 2; ++ai) {
                f32x4 x[4][2][2];
#pragma unroll
                for (int m = 0; m < 4; ++m) { const float* xw = xw_row(p, u.m0 + ai * 128 + wr * 64 + m * 16 + fr) + col0;
#pragma unroll
                    for (int bj = 0; bj < 2; ++bj)
#pragma unroll
                        for (int n = 0; n < 2; ++n) x[m][bj][n] = *(const f32x4*)(xw + bj * 32 + 4 * n); }
#pragma unroll
                for (int m = 0; m < 4; ++m) { float* xw = xw_row(p, u.m0 + ai * 128 + wr * 64 + m * 16 + fr) + col0;
#pragma unroll
                    for (int bj = 0; bj < 2; ++bj)
#pragma unroll
                        for (int n = 0; n < 2; ++n) *(f32x4*)(xw + bj * 32 + 4 * n) = x[m][bj][n] + g[bj][n] * acc[ai][bj][m][n]; }
                asm volatile("" ::: "memory");
            }
        }
    }
};

struct CvtJob { const float* src; int nsrc, k0, n0; bf16_t* dst; int dpitch, rowbase, rstride, blksh, f8; };
__device__ __forceinline__ CvtJob cvt_job_dense(KP p, int idx) {
    CvtJob j; const int l = idx / 120, r = idx % 120;
    if (r < 88) { const int kt = r / 11, nt = r % 11; j.src = p->in[I_WIN] + (size_t)l * D * DIN; j.nsrc = DIN; j.k0 = kt * 128; j.n0 = nt * 256; j.dst = (bf16_t*)(p->ws + WS_WIN) + (size_t)l * DIN * D; j.dpitch = D; j.rowbase = nt * 256; j.rstride = 128; j.blksh = 7; j.f8 = 0; }
    else { const int q = r - 88, kt = q / 4, nt = q % 4; j.src = p->in[I_WOUT] + (size_t)l * D * D; j.nsrc = D; j.k0 = kt * 128; j.n0 = nt * 256; j.dst = (bf16_t*)(p->ws + WS_WOUT) + (size_t)l * D * D; j.dpitch = D; j.rowbase = nt * 256; j.rstride = 128; j.blksh = 7; j.f8 = 0; }
    return j;
}
__device__ __forceinline__ CvtJob cvt_job_expert(KP p, int l, int idx) {
    CvtJob j; const int e = idx / 24, r = idx % 24, part = r >> 3, tile = r & 7;
    unsigned char* wb = p->ws + WS_WEXP + (size_t)l * WEXP_LAYER + (size_t)e * WEXP_STRIDE;
    if (part < 2) {
        const float* s = part == 0 ? (e < 64 ? p->in[I_WGATE] + ((size_t)l * NE + e) * D * DE : p->in[I_SGATE] + (size_t)l * D * DE)
                                   : (e < 64 ? p->in[I_WUP] + ((size_t)l * NE + e) * D * DE : p->in[I_SUP] + (size_t)l * D * DE);
        j.src = s; j.nsrc = DE; j.k0 = tile * 128; j.n0 = 0; j.dst = (bf16_t*)wb; j.dpitch = D; j.rowbase = part * 32; j.rstride = 64; j.blksh = 5; j.f8 = 1;
    } else {
        const float* s = e < 64 ? p->in[I_WDOWN] + ((size_t)l * NE + e) * DE * D : p->in[I_SDOWN] + (size_t)l * DE * D;
        const int kt = tile >> 2, nt = tile & 3;
        j.src = s; j.nsrc = D; j.k0 = kt * 128; j.n0 = nt * 256; j.dst = (bf16_t*)(wb + WEXP_DOWN); j.dpitch = DE; j.rowbase = nt * 256; j.rstride = 128; j.blksh = 7; j.f8 = 1;
    }
    return j;
}
constexpr int CVT_PITCH = 272;
__device__ __forceinline__ void cvt_load(const CvtJob& j, int w, int lane, f32x4 (&r)[16]) {
    const float* s = j.src + (size_t)(j.k0 + w * 16) * j.nsrc + j.n0 + lane * 4;
#pragma unroll
    for (int q = 0; q < 16; ++q) r[q] = __builtin_nontemporal_load((const f32x4*)(s + (size_t)q * j.nsrc));
}
__device__ __forceinline__ void cvt_to_lds(LAS unsigned char* lds, int w, int lane, const f32x4 (&r)[16], int f8) {
    if (f8) {
#pragma unroll
        for (int jn = 0; jn < 4; ++jn) { int q[4];
#pragma unroll
            for (int g = 0; g < 4; ++g) { int v = 0; v = __builtin_amdgcn_cvt_pk_fp8_f32(r[4 * g][jn] * 16.0f, r[4 * g + 1][jn] * 16.0f, v, false); v = __builtin_amdgcn_cvt_pk_fp8_f32(r[4 * g + 2][jn] * 16.0f, r[4 * g + 3][jn] * 16.0f, v, true); q[g] = v; }
            *(LAS pg8::u32x4*)(lds + (lane * 4 + jn) * 144 + w * 16) = (pg8::u32x4){(unsigned)q[0], (unsigned)q[1], (unsigned)q[2], (unsigned)q[3]}; }
        return;
    }
#pragma unroll
    for (int jn = 0; jn < 4; ++jn)
#pragma unroll
        for (int g = 0; g < 2; ++g) {
            pg8::u32x4 v; v.x = pg8::cvt_pk_bf16(r[g * 8 + 0][jn], r[g * 8 + 1][jn]); v.y = pg8::cvt_pk_bf16(r[g * 8 + 2][jn], r[g * 8 + 3][jn]);
            v.z = pg8::cvt_pk_bf16(r[g * 8 + 4][jn], r[g * 8 + 5][jn]); v.w = pg8::cvt_pk_bf16(r[g * 8 + 6][jn], r[g * 8 + 7][jn]);
            *(LAS pg8::u32x4*)(lds + (lane * 4 + jn) * CVT_PITCH + (w * 16 + g * 8) * 2) = v;
        }
}
__device__ __forceinline__ void cvt_write_out(const CvtJob& j, const LAS unsigned char* lds, int tid) {
    if (j.f8) {
#pragma unroll
        for (int rr = 0; rr < 4; ++rr) { const int n = (tid >> 3) + 64 * rr, kc = tid & 7;
            const pg8::u32x4 v = *(const LAS pg8::u32x4*)(lds + n * 144 + kc * 16);
            const int drow = j.rowbase + (n >> j.blksh) * j.rstride + (n & ((1 << j.blksh) - 1));
            *(pg8::u32x4*)((unsigned char*)j.dst + (size_t)drow * j.dpitch + j.k0 + kc * 16) = v; }
        return;
    }
#pragma unroll
    for (int rr = 0; rr < 8; ++rr) { const int n = (tid >> 4) + 32 * rr, kc = tid & 15;
        const pg8::u32x4 v = *(const LAS pg8::u32x4*)(lds + n * CVT_PITCH + kc * 16);
        const int drow = j.rowbase + (n >> j.blksh) * j.rstride + (n & ((1 << j.blksh) - 1));
        *(pg8::u32x4*)(j.dst + (size_t)drow * j.dpitch + j.k0 + kc * 8) = v; }
}
__device__ __forceinline__ void convert_weights(KP p, LAS unsigned char* lds, int nd, int ne, int l, const int tid) {
    const int w = tid >> 6, lane = tid & 63; const int ntot = nd + ne;
    int idx = blockIdx.x; if (idx >= ntot) return;
    CvtJob cur = idx < nd ? cvt_job_dense(p, idx) : cvt_job_expert(p, l, idx - nd);
    f32x4 r[16];
    cvt_load(cur, w, lane, r);
    for (;;) {
        __syncthreads();
        cvt_to_lds(lds, w, lane, r, cur.f8);
        __syncthreads();
        const int nidx = idx + gridDim.x; const bool more = nidx < ntot;
        CvtJob nx = cur;
        if (more) { nx = nidx < nd ? cvt_job_dense(p, nidx) : cvt_job_expert(p, l, nidx - nd); cvt_load(nx, w, lane, r); }
        cvt_write_out(cur, lds, tid);
        if (!more) break;
        cur = nx; idx = nidx;
    }
    __syncthreads();
}

struct GroupMap { LAS int* tstart; LAS int* sbase; LAS int* cnt; };
__device__ __forceinline__ GroupMap build_group_map(KP p, int l, LAS int* base, int TM, int nrows, const int tid) {
    GroupMap g; g.tstart = base; g.sbase = base + 72; g.cnt = base + 144;
    const unsigned* counts = (const unsigned*)(p->ws + WS_CTL) + CW_CNT + l * 64;
    if (tid < 64) {
        int c = (int)counts[tid]; if (c > nrows) c = nrows;
        const int tl = (c + TM - 1) / TM, pd = (c + 255) & ~255;
        int st = tl, sp = pd;
#pragma unroll
        for (int o = 1; o < 64; o <<= 1) { const int a = __shfl_up(st, o), b = __shfl_up(sp, o); if (tid >= o) { st += a; sp += b; } }
        g.tstart[tid] = st - tl; g.sbase[tid] = sp - pd; g.cnt[tid] = c;
        if (tid == 63) { g.tstart[64] = st; g.sbase[64] = HID_SHARED_BASE; g.cnt[64] = nrows; g.tstart[65] = st + (nrows + TM - 1) / TM; }
    }
    __syncthreads();
    return g;
}

__device__ __forceinline__ void phase_moe_up(KP p, int l, LAS float* sm) {
    const int tid = opaque_tid(), ty = tid >> 4, tx = tid & 15;
    LAS int* rowidx = (LAS int*)(sm + 16 * 132 + 2 * 16 * 128);
    LAS float* gates = (LAS float*)(rowidx + 128);
    LAS int* gm = (LAS int*)(gates + 128);
    const int nrows = (l == 0) ? RT : RL;
    const GroupMap G = build_group_map(p, l, gm, 128, nrows, tid);
    const bf16_t* HB = (const bf16_t*)(p->ws + WS_HB); bf16_t* HID = (bf16_t*)(p->ws + WS_HID);
    const uint2* LIST = (const uint2*)(p->ws + WS_LIST);
    const int ntiles = G.tstart[65];
    for (int u = blockIdx.x; u < ntiles * 2; u += gridDim.x) {
        const int t = u >> 1, nt = u & 1;
        int e = 0; while (G.tstart[e + 1] <= t) ++e;
        const int m0 = (t - G.tstart[e]) * 128, cnt = G.cnt[e];
        __syncthreads();
        if (tid < 128) {
            const int m = m0 + tid;
            if (m < cnt) { if (e < 64) { const uint2 en = LIST[(size_t)e * RT + m]; rowidx[tid] = (int)(en.x >> 3); gates[tid] = __uint_as_float(en.y); } else { rowidx[tid] = m; gates[tid] = 1.0f; } }
            else { rowidx[tid] = -1; gates[tid] = 0.f; }
        }
        __syncthreads();
        const float* Wg = e < 64 ? p->in[I_WGATE] + ((size_t)l * NE + e) * D * DE : p->in[I_SGATE] + (size_t)l * D * DE;
        const float* Wu = e < 64 ? p->in[I_WUP] + ((size_t)l * NE + e) * D * DE : p->in[I_SUP] + (size_t)l * D * DE;
        float acc[4][8], acc2[4][8];
        sgemm_tile<true, true>(sm, HB, D, rowidx, Wg, Wu, DE, nt * 128, D, acc, acc2, tid);
#pragma unroll
        for (int i = 0; i < 4; ++i) { const int mi = ty * 4 + i; const int m = m0 + mi;
            if (m < cnt) { const float gt = gates[mi]; bf16_t* hp = HID + (size_t)(G.sbase[e] + m) * DE + nt * 128 + tx * 8;
#pragma unroll
                for (int j = 0; j < 8; ++j) hp[j] = f2bf(silu_f(acc[i][j]) * acc2[i][j] * gt); } }
    }
}

__device__ __forceinline__ void phase_moe_down(KP p, int l, LAS float* sm) {
    const int tid = opaque_tid(), ty = tid >> 4, tx = tid & 15;
    LAS int* rowidx = (LAS int*)(sm + 16 * 132 + 2 * 16 * 128);
    LAS int* pairs = rowidx + 128;
    LAS int* gm = pairs + 128;
    const int nrows = (l == 0) ? RT : RL;
    const GroupMap G = build_group_map(p, l, gm, 128, nrows, tid);
    const bf16_t* HID = (const bf16_t*)(p->ws + WS_HID); bf16_t* ROWS = (bf16_t*)(p->ws + WS_ROWS);
    const uint2* LIST = (const uint2*)(p->ws + WS_LIST);
    const float* MOD = (const float*)(p->ws + WS_MOD) + (size_t)l * 9 * 6144;
    const int ntiles = G.tstart[65];
    for (int u = blockIdx.x; u < ntiles * 8; u += gridDim.x) {
        const int t = u >> 3, nt = u & 7;
        int e = 0; while (G.tstart[e + 1] <= t) ++e;
        const int m0 = (t - G.tstart[e]) * 128, cnt = G.cnt[e];
        __syncthreads();
        if (tid < 128) {
            const int m = m0 + tid;
            if (m < cnt) { rowidx[tid] = G.sbase[e] + m; pairs[tid] = e < 64 ? (int)LIST[(size_t)e * RT + m].x : m; }
            else { rowidx[tid] = -1; pairs[tid] = -1; }
        }
        __syncthreads();
        const float* Wd = e < 64 ? p->in[I_WDOWN] + ((size_t)l * NE + e) * DE * D : p->in[I_SDOWN] + (size_t)l * DE * D;
        float acc[4][8], acc2[4][8];
        sgemm_tile<true, false>(sm, HID, DE, rowidx, Wd, nullptr, D, nt * 128, DE, acc, acc2, tid);
#pragma unroll
        for (int i = 0; i < 4; ++i) { const int mi = ty * 4 + i; const int pr = pairs[mi];
            if (pr >= 0) {
                if (e < 64) { bf16_t* rp = ROWS + (size_t)pr * D + nt * 128 + tx * 8;
#pragma unroll
                    for (int j = 0; j < 8; ++j) rp[j] = f2bf(acc[i][j]); }
                else { const int bb = row_bb(pr); float* xw = xw_row(p, pr) + nt * 128 + tx * 8; const float* g2 = MOD + bb * 6144 + 5120 + nt * 128 + tx * 8;
#pragma unroll
                    for (int j = 0; j < 8; ++j) xw[j] += g2[j] * acc[i][j]; }
            } }
    }
}


#ifndef GP_ALIGN
#define GP_ALIGN true
#endif
#ifndef GP_SP2
#define GP_SP2 true
#endif
constexpr int GM_OFF = 131072;
__device__ __forceinline__ void tail_fill(KP p, LAS unsigned char* lds, int nU, int ql, int per_unit);
__device__ __forceinline__ void phase_inproj_fast(KP p, int l, LAS unsigned char* lds) {
    const int tid = opaque_tid();
    pg8::SchedDense S; S.K = D; S.G = gridDim.x; S.c = blockIdx.x; S.Bt = (const char*)(p->ws + WS_WIN) + (size_t)l * DIN * D * 2; S.nN = DIN / 256;
    if (l == 0) { S.nM = RT / 256; S.nExtra = 0; S.xpm0 = 0; S.xpn0 = 0; S.xn = 1; }
    else { S.nM = RL / 256; S.nExtra = (RC / 256) * 4; S.xpm0 = RL / 256; S.xpn0 = OFF_K / 256; S.xn = 4; }
    S.nwg = S.nM * S.nN;
    EpiInproj E{(bf16_t*)(p->ws + WS_PB)};
    pg8::gemm_phase<GP_ALIGN, GP_SP2, false, false, 127>(lds, (const char*)(p->ws + (l == 0 ? WS_HB : WS_HID)), D, S, E, tid);
    tail_fill(p, lds, S.nwg + S.nExtra, l, 4);
}
__device__ __forceinline__ void phase_outproj_fast(KP p, int l, LAS unsigned char* lds) {
    const int tid = opaque_tid();
    pg8::SchedDense S; S.K = D; S.G = gridDim.x; S.c = blockIdx.x; S.Bt = (const char*)(p->ws + WS_WOUT) + (size_t)l * D * D * 2; S.nN = D / 256;
    S.nM = (l == 0 ? RT : RL) / 256; S.nExtra = 0; S.xpm0 = 0; S.xpn0 = 0; S.xn = 1; S.nwg = S.nM * S.nN;
    EpiOutproj E{(bf16_t*)(p->ws + WS_Y)};
    pg8::gemm_phase<GP_ALIGN, GP_SP2, false, false, 127>(lds, (const char*)(p->ws + WS_MIX), D, S, E, tid);
    tail_fill(p, lds, S.nwg, l, 4);
}
__device__ __forceinline__ void phase_moe_up_fast(KP p, int l, LAS unsigned char* lds) {
    const int tid = opaque_tid();
    const int nrows = (l == 0) ? RT : RL;
    const GroupMap G = build_group_map(p, l, (LAS int*)(lds + GM_OFF), 256, nrows, tid);
    pg8::SchedMoe<true> S; S.tstart = G.tstart; S.sbase = G.sbase; S.cntv = G.cnt; S.NPN = 2; S.G = gridDim.x; S.c = blockIdx.x; S.nU = G.tstart[65] * 2; S.K = D / 2;
    S.Wbase = (const char*)(p->ws + WS_WEXP + (size_t)l * WEXP_LAYER); S.LIST = (const uint2*)(p->ws + WS_LIST);
    EpiMoeUp E{(const uint2*)(p->ws + WS_LIST), (bf16_t*)(p->ws + WS_HID)};
    pg8::gemm_phase<GP_ALIGN, false, true, true, 123>(lds, (const char*)(p->ws + WS_HB), D / 2, S, E, tid);
    if (l == 0) tail_fill(p, lds, S.nU, 1, 4);
}
__device__ __forceinline__ void phase_moe_down_fast(KP p, int l, LAS unsigned char* lds) {
    const int tid = opaque_tid();
    const int nrows = (l == 0) ? RT : RL;
    const GroupMap G = build_group_map(p, l, (LAS int*)(lds + GM_OFF), 256, nrows, tid);
    pg8::SchedMoe<false> S; S.tstart = G.tstart; S.sbase = G.sbase; S.cntv = G.cnt; S.NPN = 4; S.G = gridDim.x; S.c = blockIdx.x; S.nU = G.tstart[65] * 4; S.K = DE / 2;
    S.Wbase = (const char*)(p->ws + WS_WEXP + (size_t)l * WEXP_LAYER + WEXP_DOWN); S.LIST = (const uint2*)(p->ws + WS_LIST);
    EpiMoeDown E{(const uint2*)(p->ws + WS_LIST), (bf16_t*)(p->ws + WS_ROWS), p, (const float*)(p->ws + WS_MOD) + (size_t)l * 9 * 6144 + 5120};
    int Kd = DE / 2; asm volatile("" : "+s"(Kd));
    S.K = Kd;
    pg8::gemm_phase<GP_ALIGN, false, true, true, 123>(lds, (const char*)(p->ws + WS_HID), Kd, S, E, tid);
    if (l == 0) tail_fill(p, lds, S.nU, 1, 2);
}

constexpr int WSD_PITCH = 272, WSD_IMG = 512 * WSD_PITCH, WSD_TAB = WSD_IMG;
__device__ __forceinline__ void phase_moe_down_ws(KP p, int l, LAS char* lds) {
    typedef int i32x8 __attribute__((ext_vector_type(8)));
    const int tid = opaque_tid(), lane = tid & 63, wave = tid >> 6, r16 = lane & 15, kb = lane >> 4;
    const int nrows = (l == 0) ? RT : RL;
    const GroupMap G = build_group_map(p, l, (LAS int*)(lds + WSD_TAB), 256, nrows, tid);
    LAS int* istart = (LAS int*)(lds + WSD_TAB + 1024);
    if (tid < 64) {
        const int np = (G.cnt[tid] + 63) >> 6, nch = (np + 15) >> 4, ppc = nch ? (np + nch - 1) / nch : 0;
        int it = nch * 2, st = it;
#pragma unroll
        for (int o = 1; o < 64; o <<= 1) { const int a = __shfl_up(st, o); if (tid >= o) st += a; }
        istart[tid] = st - it; istart[66 + tid] = ppc;
        if (tid == 63) { const int nps = (nrows + 63) >> 6, nchs = (nps + 15) >> 4; istart[64] = st; istart[65] = st + nchs * 2; istart[66 + 64] = (nps + nchs - 1) / nchs; }
    }
    __syncthreads();
    const int nitems = istart[65];
    const uint2* LIST = (const uint2*)(p->ws + WS_LIST);
    const unsigned char* HID = (const unsigned char*)(p->ws + WS_HID);
    unsigned char* ROWS = (unsigned char*)(p->ws + WS_ROWS);
    const float* g2 = (const float*)(p->ws + WS_MOD) + (size_t)l * 9 * 6144 + 5120;
    for (int L = blockIdx.x; L < nitems; L += gridDim.x) {
        const int itx = pg8::xcd_remap(L, nitems);
        const int e = __builtin_popcountll(__ballot(istart[(lane) + 1] <= itx));
        const int loc = itx - istart[e], half = loc & 1, chunk = loc >> 1, ppc = istart[66 + e];
        const int cnt = G.cnt[e], sb = G.sbase[e];
        const int np = (cnt + 63) >> 6, p0 = chunk * ppc, p1 = (p0 + ppc < np) ? p0 + ppc : np;
        {
            const unsigned char* Wsrc = (const unsigned char*)(p->ws + WS_WEXP + (size_t)l * WEXP_LAYER + (size_t)e * WEXP_STRIDE + WEXP_DOWN) + (size_t)half * 512 * 256;
            pg8::u32x4 wv[16];
            int tq = tid; asm volatile("" : "+v"(tq));
#pragma unroll
            for (int i = 0; i < 16; ++i) { const int idx = tq + 512 * i, rho = idx >> 4, pc = idx & 15, ct = rho >> 4, c = rho & 15;
                const int col = 128 * (ct >> 3) + 32 * (c >> 2) + 4 * (ct & 7) + (c & 3);
                wv[i] = *(const pg8::u32x4*)(Wsrc + (size_t)col * 256 + pc * 16); }
            __syncthreads();
#pragma unroll
            for (int i = 0; i < 16; ++i) { const int idx = tq + 512 * i, rho = idx >> 4, pc = idx & 15; *(LAS pg8::u32x4*)(lds + rho * WSD_PITCH + pc * 16) = wv[i]; }
            __syncthreads();
        }
        const LAS char* wl = lds + r16 * WSD_PITCH + kb * 32;
        const int bb_sh = 0;
        for (int ps = p0 + wave; ps < p1; ps += NWAVES) {
            const int slot0 = ps * 64;
            i32x8 hf[4][2]; unsigned pr[4];
#pragma unroll
            for (int g = 0; g < 4; ++g) { const int slot = slot0 + g * 16 + r16; const unsigned char* hp = HID + (size_t)(sb + slot) * DE + kb * 32;
                const pg8::u32x4 a0 = *(const pg8::u32x4*)hp, a1 = *(const pg8::u32x4*)(hp + 16), b0 = *(const pg8::u32x4*)(hp + 128), b1 = *(const pg8::u32x4*)(hp + 144);
                hf[g][0] = (i32x8){(int)a0.x, (int)a0.y, (int)a0.z, (int)a0.w, (int)a1.x, (int)a1.y, (int)a1.z, (int)a1.w};
                hf[g][1] = (i32x8){(int)b0.x, (int)b0.y, (int)b0.z, (int)b0.w, (int)b1.x, (int)b1.y, (int)b1.z, (int)b1.w};
                pr[g] = e < 64 ? LIST[(size_t)e * RT + slot].x : (unsigned)(RT * 8 + slot); }
#define WSD_WFRAG(t) const LAS char* wp = wl + (g8 * 8 + (t)) * 16 * WSD_PITCH; \
                    const pg8::u32x4 w0 = *(const LAS pg8::u32x4*)wp, w1 = *(const LAS pg8::u32x4*)(wp + 16), w2 = *(const LAS pg8::u32x4*)(wp + 128), w3 = *(const LAS pg8::u32x4*)(wp + 144); \
                    const i32x8 wf0 = {(int)w0.x, (int)w0.y, (int)w0.z, (int)w0.w, (int)w1.x, (int)w1.y, (int)w1.z, (int)w1.w}; \
                    const i32x8 wf1 = {(int)w2.x, (int)w2.y, (int)w2.z, (int)w2.w, (int)w3.x, (int)w3.y, (int)w3.z, (int)w3.w};
            {
#pragma unroll 1
                for (int g8 = 0; g8 < 4; ++g8) {
                    int ow[4][8];
#pragma unroll
                    for (int t = 0; t < 8; ++t) { WSD_WFRAG(t)
#pragma unroll
                        for (int g = 0; g < 4; ++g) { f32x4 acc = {0.f, 0.f, 0.f, 0.f};
                            acc = __builtin_amdgcn_mfma_scale_f32_16x16x128_f8f6f4(wf0, hf[g][0], acc, 0, 0, 0, 123, 0, 123);
                            acc = __builtin_amdgcn_mfma_scale_f32_16x16x128_f8f6f4(wf1, hf[g][1], acc, 0, 0, 0, 123, 0, 123);
                            int w = 0; w = __builtin_amdgcn_cvt_pk_fp8_f32(acc[0] * ROWS_SCALE, acc[1] * ROWS_SCALE, w, false); w = __builtin_amdgcn_cvt_pk_fp8_f32(acc[2] * ROWS_SCALE, acc[3] * ROWS_SCALE, w, true); ow[g][t] = w; }
                        if (t & 1) __builtin_amdgcn_sched_barrier(0);
                    }
#pragma unroll
                    for (int g = 0; g < 4; ++g) { const int slot = slot0 + g * 16 + r16;
                        if (slot < cnt) { unsigned char* dst = ROWS + (size_t)pr[g] * D + half * 512 + g8 * 128 + kb * 32;
                            *(pg8::u32x4*)dst = (pg8::u32x4){(unsigned)ow[g][0], (unsigned)ow[g][1], (unsigned)ow[g][2], (unsigned)ow[g][3]};
                            *(pg8::u32x4*)(dst + 16) = (pg8::u32x4){(unsigned)ow[g][4], (unsigned)ow[g][5], (unsigned)ow[g][6], (unsigned)ow[g][7]}; } }
                }
            }
#undef WSD_WFRAG
        }
        (void)bb_sh;
    }
    __syncthreads();
    if (l == 0) tail_fill(p, (LAS unsigned char*)lds, nitems, 1, 2);
}
__device__ __forceinline__ void phase_convert(KP p, LAS unsigned char* lds, int nd, int ne, int l) {
    const int tid = opaque_tid();
    convert_weights(p, lds, nd, ne, l, tid);
}
constexpr int NCVT = 1560, CVT_WORD = 69632;
__device__ __forceinline__ int cvt_claim(KP p, LAS unsigned char* lds, int l, const int tid) {
    if (tid == 0) *(LAS int*)(lds + CVT_WORD) = (int)atomicAdd((unsigned*)(p->ws + WS_CTL) + CW_CVT + l * 64, 1u);
    __syncthreads();
    const int j = *(const LAS int*)(lds + CVT_WORD);
    __syncthreads();
    return j;
}
__device__ __forceinline__ void convert_queue(KP p, LAS unsigned char* lds, int l, int budget, const int tid) {
    const int w = tid >> 6, lane = tid & 63;
    int j = cvt_claim(p, lds, l, tid); if (j >= NCVT) return;
    CvtJob cur = cvt_job_expert(p, l, j);
    f32x4 r[16];
    cvt_load(cur, w, lane, r);
    int done = 0;
    for (;;) {
        __syncthreads();
        cvt_to_lds(lds, w, lane, r, cur.f8);
        __syncthreads();
        ++done;
        int jn = NCVT; if (budget < 0 || done < budget) jn = cvt_claim(p, lds, l, tid);
        const bool more = jn < NCVT;
        CvtJob nx = cur;
        if (more) { nx = cvt_job_expert(p, l, jn); cvt_load(nx, w, lane, r); }
        cvt_write_out(cur, lds, tid);
        if (!more) break;
        cur = nx;
    }
    __syncthreads();
}
__device__ __forceinline__ void tail_fill(KP p, LAS unsigned char* lds, int nU, int ql, int per_unit) {
    const int G = gridDim.x, c = blockIdx.x;
    const int mine = c < nU ? (nU - c + G - 1) / G : 0, mx = (nU + G - 1) / G;
    if (mine < mx) { const int tid = opaque_tid(); convert_queue(p, lds, ql, (mx - mine) * per_unit, tid); }
}

__device__ __forceinline__ void phase_router_fast(KP p, int l, char* lds) {
    using att::bf16x8; using att::f32x16;
    const int tid = opaque_tid(), lane = tid & 63, wave = tid >> 6;
    constexpr int APITCH = 2064, MAXSEL = 2048;
    char* A_lds = lds;
    float* red = (float*)(lds + 67584);
    unsigned* sel_pair = (unsigned*)(lds + 100352); float* sel_gate = (float*)(lds + 100352 + 4 * MAXSEL); unsigned* sel_eidx = (unsigned*)(lds + 100352 + 8 * MAXSEL);
    unsigned* lcnt = (unsigned*)(lds + 100352 + 12 * MAXSEL); unsigned* lbase = lcnt + 64;
    const float* MOD = (const float*)(p->ws + WS_MOD) + (size_t)l * 9 * 6144;
    bf16_t* HB = (bf16_t*)(p->ws + WS_HB);
    const bf16_t* Y = (const bf16_t*)(p->ws + WS_Y);
    unsigned* counts = (unsigned*)(p->ws + WS_CTL) + CW_CNT + l * 64;
    uint2* LIST = (uint2*)(p->ws + WS_LIST);
    const bf16_t* WRT = (const bf16_t*)(p->ws + WS_WR) + (size_t)l * NE * D;
    const float* gn = p->in[I_GN2] + l * D;
    const float brt = p->in[I_BROUTER][l * NE + lane];
    const int nunits = ((l == 0) ? RT : RL) / 32;
    if (tid < 64) lcnt[tid] = 0u;
    __syncthreads();
    int it = 0;
    for (int u = blockIdx.x; u < nunits; u += gridDim.x, ++it) {
        const int r0 = u * 32, bb = row_bb(r0);
        f32x4 v[4][4]; uint2 yv[4][4];
#pragma unroll
        for (int i = 0; i < 4; ++i) { const float* xr = xsrc_row(p, l, r0 + 4 * wave + i) + lane * 4; const bf16_t* yr = Y + (size_t)(r0 + 4 * wave + i) * D + lane * 4;
#pragma unroll
            for (int j = 0; j < 4; ++j) { v[i][j] = *(const f32x4*)(xr + 256 * j); yv[i][j] = *(const uint2*)(yr + 256 * j); } }
        f32x4 ga[4], sh[4], g1[4];
#pragma unroll
        for (int j = 0; j < 4; ++j) { const int c = lane * 4 + 256 * j; const f32x4 g = *(const f32x4*)(gn + c), s1 = *(const f32x4*)(MOD + bb * 6144 + 4096 + c);
            ga[j] = g * (1.0f + s1); sh[j] = *(const f32x4*)(MOD + bb * 6144 + 3072 + c); g1[j] = *(const f32x4*)(MOD + bb * 6144 + 2048 + c); }
#pragma unroll
        for (int i = 0; i < 4; ++i) {
            const int rl = 4 * wave + i;
            float ss = 0.f;
#pragma unroll
            for (int j = 0; j < 4; ++j) {
                const f32x4 yf = {__uint_as_float(yv[i][j].x << 16), __uint_as_float(yv[i][j].x & 0xffff0000u), __uint_as_float(yv[i][j].y << 16), __uint_as_float(yv[i][j].y & 0xffff0000u)};
                v[i][j] = v[i][j] + g1[j] * yf;
                ss += v[i][j].x * v[i][j].x + v[i][j].y * v[i][j].y + v[i][j].z * v[i][j].z + v[i][j].w * v[i][j].w; }
            ss = wave_sum(ss);
            const float inv = rsqrtf(ss * (1.0f / D) + EPS);
#pragma unroll
            for (int j = 0; j < 4; ++j) { const int c = lane * 4 + 256 * j; const f32x4 h = v[i][j] * inv * ga[j] + sh[j];
                uint2 w; w.x = pg8::cvt_pk_bf16(h.x, h.y); w.y = pg8::cvt_pk_bf16(h.z, h.w);
                *(uint2*)(A_lds + rl * APITCH + c * 2) = w;
                int w8 = 0; w8 = __builtin_amdgcn_cvt_pk_fp8_f32(h.x * 16.0f, h.y * 16.0f, w8, false); w8 = __builtin_amdgcn_cvt_pk_fp8_f32(h.z * 16.0f, h.w * 16.0f, w8, true);
                *(int*)((unsigned char*)HB + (size_t)(r0 + rl) * D + c) = w8; }
        }
        __syncthreads();
        {
            const int nt = wave & 1, kq = wave >> 1, r32 = lane & 31, hh = lane >> 5;
            f32x16 acc = {};
            const bf16_t* Wt = WRT + (size_t)(nt * 32 + r32) * D + kq * 256 + hh * 8;
            const char* Ap = A_lds + r32 * APITCH + (kq * 256 + hh * 8) * 2;
#pragma unroll
            for (int s = 0; s < 16; ++s) { const bf16x8 a = *(const bf16x8*)(Ap + s * 32); const bf16x8 b = *(const bf16x8*)(Wt + s * 16);
                acc = __builtin_amdgcn_mfma_f32_32x32x16_bf16(a, b, acc, 0, 0, 0); }
#pragma unroll
            for (int r = 0; r < 16; ++r) red[((kq * 2 + nt) * 32 + att::crow(r, hh)) * 32 + r32] = acc[r];
        }
        __syncthreads();
#pragma unroll 1
        for (int i = 0; i < 4; ++i) {
            const int rl = 4 * wave + i, r = r0 + rl; const int et = lane >> 5, ec = lane & 31;
            float logit = 0.f;
#pragma unroll
            for (int kq = 0; kq < 4; ++kq) logit += red[((kq * 2 + et) * 32 + rl) * 32 + ec];
            const float score = 1.0f / (1.0f + expf(-logit));
            float key = score + brt;
            float ssum = 0.f; int myrank = -1;
#pragma unroll 1
            for (int k = 0; k < TOPK; ++k) {
                const float mx = wave_max(key);
                const unsigned long long bal = __ballot(key == mx);
                const int win = __ffsll((long long)bal) - 1;
                ssum += __shfl(score, win);
                if (lane == win) { myrank = k; key = -1e30f; }
            }
            if (myrank >= 0) {
                const unsigned li = atomicAdd(&lcnt[lane], 1u);
                const int sidx = ((it * 32 + rl) * 8 + myrank) & (MAXSEL - 1);
                sel_pair[sidx] = (unsigned)(r * 8 + myrank); sel_gate[sidx] = score / ssum * 2.5f; sel_eidx[sidx] = ((unsigned)lane << 16) | li;
            }
        }
        __syncthreads();
    }
    if (tid < 64) lbase[tid] = atomicAdd(&counts[tid], lcnt[tid]);
    __syncthreads();
    const int nsel = it * 256;
    for (int s = tid; s < nsel; s += NTHREADS) { const unsigned ei = sel_eidx[s], e = ei >> 16, li = ei & 0xffffu;
        uint2 en; en.x = sel_pair[s]; en.y = __float_as_uint(sel_gate[s]);
        LIST[(size_t)e * RT + lbase[e] + li] = en; }
    __syncthreads();
}

__device__ __forceinline__ void phase_gmlp_fast(KP p, int l, char* lds) {
    using att::bf16x8;
    const int tid = opaque_tid(), lane = tid & 63, wave = tid >> 6, fr = lane & 15, fq = lane >> 4;
    bf16_t* PB = (bf16_t*)(p->ws + WS_PB); bf16_t* MIX = (bf16_t*)(p->ws + WS_MIX);
    constexpr int VPITCH = 272;
    char* VT = lds;
    const int nchunks = (l == 0 ? RT : RL) / 128;
    const bf16_t* WSB = (const bf16_t*)(p->ws + WS_WSB) + (size_t)l * 4 * 128 * 128;
    const float* gv = p->in[I_GV] + l * 256; const float* bs = p->in[I_BS] + l * 4 * 128;
    for (int ch = blockIdx.x; ch < nchunks; ch += gridDim.x) {
        const int r0 = ch * 128;
        uint2 vv[16];
#pragma unroll
        for (int i = 0; i < 16; ++i) vv[i] = *(const uint2*)(PB + (size_t)(r0 + 16 * wave + i) * DIN + OFF_AV + lane * 4);
        const f32x4 g4 = *(const f32x4*)(gv + lane * 4);
#pragma unroll
        for (int i = 0; i < 16; i += 2) {
            float a[2][4];
#pragma unroll
            for (int t = 0; t < 2; ++t) { a[t][0] = __uint_as_float(vv[i + t].x << 16); a[t][1] = __uint_as_float(vv[i + t].x & 0xffff0000u); a[t][2] = __uint_as_float(vv[i + t].y << 16); a[t][3] = __uint_as_float(vv[i + t].y & 0xffff0000u); }
            const float s0 = wave_sum(a[0][0] * a[0][0] + a[0][1] * a[0][1] + a[0][2] * a[0][2] + a[0][3] * a[0][3]);
            const float s1 = wave_sum(a[1][0] * a[1][0] + a[1][1] * a[1][1] + a[1][2] * a[1][2] + a[1][3] * a[1][3]);
            const float i0 = rsqrtf(s0 * (1.0f / 256.0f) + EPS), i1 = rsqrtf(s1 * (1.0f / 256.0f) + EPS);
#pragma unroll
            for (int j = 0; j < 4; ++j) *(unsigned*)(VT + (lane * 4 + j) * VPITCH + (16 * wave + i) * 2) = pg8::cvt_pk_bf16(a[0][j] * i0 * g4[j], a[1][j] * i1 * g4[j]);
        }
        __syncthreads();
        const int pp = 16 * wave + fr;
#pragma unroll 1
        for (int g = 0; g < 4; ++g) {
            bf16x8 bw[4];
#pragma unroll
            for (int s = 0; s < 4; ++s) bw[s] = *(const bf16x8*)(WSB + (size_t)(g * 128 + pp) * 128 + s * 32 + fq * 8);
            f32x4 acc[4];
#pragma unroll
            for (int dt = 0; dt < 4; ++dt) { acc[dt] = (f32x4){0.f, 0.f, 0.f, 0.f};
#pragma unroll
                for (int s = 0; s < 4; ++s) { const bf16x8 a = *(const bf16x8*)(VT + (g * 64 + dt * 16 + fr) * VPITCH + (s * 32 + fq * 8) * 2);
                    acc[dt] = __builtin_amdgcn_mfma_f32_16x16x32_bf16(a, bw[s], acc[dt], 0, 0, 0); } }
            const float bias = bs[g * 128 + pp];
#pragma unroll
            for (int dt = 0; dt < 4; ++dt) { const int c = g * 64 + dt * 16 + 4 * fq;
                const uint2 uw = *(const uint2*)(PB + (size_t)(r0 + pp) * DIN + OFF_AU + c);
                const float u0 = __uint_as_float(uw.x << 16), u1 = __uint_as_float(uw.x & 0xffff0000u), u2 = __uint_as_float(uw.y << 16), u3 = __uint_as_float(uw.y & 0xffff0000u);
                uint2 w; w.x = pg8::cvt_pk_bf16(u0 * (acc[dt][0] + bias), u1 * (acc[dt][1] + bias)); w.y = pg8::cvt_pk_bf16(u2 * (acc[dt][2] + bias), u3 * (acc[dt][3] + bias));
                *(uint2*)(MIX + (size_t)(r0 + pp) * D + c) = w; }
        }
        __syncthreads();
    }
}

__device__ __forceinline__ void phase_combine_fast(KP p, int l) {
    typedef float f32x2v __attribute__((ext_vector_type(2)));
    const int tid = opaque_tid(), lane = tid & 63, gw = blockIdx.x * NWAVES + (tid >> 6), NGW = gridDim.x * NWAVES;
    const unsigned char* ROWS = (const unsigned char*)(p->ws + WS_ROWS);
    const bf16_t* Y = (const bf16_t*)(p->ws + WS_Y);
    const float* MOD = (const float*)(p->ws + WS_MOD) + (size_t)l * 9 * 6144;
    const float* MOD1 = (const float*)(p->ws + WS_MOD) + (size_t)9 * 6144;
    bf16_t* HB = (bf16_t*)(p->ws + WS_HID);
    const float* gn1 = p->in[I_GN1] + D;
    const int nrows = (l == 0) ? RT : RL;
    for (int r0 = gw; r0 < nrows; r0 += 2 * NGW) {
        uint4 rw[2][9]; f32x4 x[2][4]; uint4 yv[2][2];
#pragma unroll
        for (int q = 0; q < 2; ++q) { const int r = r0 + q * NGW; if (r < nrows) {
#pragma unroll
            for (int k = 0; k < 8; ++k) rw[q][k] = *(const uint4*)(ROWS + ((size_t)r * 8 + k) * D + lane * 16);
            rw[q][8] = *(const uint4*)(ROWS + ((size_t)RT * 8 + r) * D + lane * 16);
            const float* xs = xsrc_row(p, l, r) + lane * 16;
#pragma unroll
            for (int c4 = 0; c4 < 4; ++c4) x[q][c4] = *(const f32x4*)(xs + 4 * c4);
            yv[q][0] = *(const uint4*)(Y + (size_t)r * D + lane * 16); yv[q][1] = *(const uint4*)(Y + (size_t)r * D + lane * 16 + 8); } }
#pragma unroll
        for (int q = 0; q < 2; ++q) { const int r = r0 + q * NGW; if (r < nrows) {
            const int bb = row_bb(r); float* xw = xw_row(p, r) + lane * 16;
            float s[16];
#pragma unroll
            for (int i = 0; i < 16; ++i) s[i] = 0.f;
#pragma unroll
            for (int k = 0; k < 9; ++k) { const unsigned w4[4] = {rw[q][k].x, rw[q][k].y, rw[q][k].z, rw[q][k].w};
#pragma unroll
                for (int i = 0; i < 4; ++i) { const f32x2v a = __builtin_amdgcn_cvt_pk_f32_fp8((int)w4[i], false), b = __builtin_amdgcn_cvt_pk_f32_fp8((int)w4[i], true);
                    s[4 * i] += a[0]; s[4 * i + 1] += a[1]; s[4 * i + 2] += b[0]; s[4 * i + 3] += b[1]; } }
            float ss = 0.f;
            const unsigned yw[8] = {yv[q][0].x, yv[q][0].y, yv[q][0].z, yv[q][0].w, yv[q][1].x, yv[q][1].y, yv[q][1].z, yv[q][1].w};
#pragma unroll
            for (int c4 = 0; c4 < 4; ++c4) { const f32x4 g = *(const f32x4*)(MOD + bb * 6144 + 5120 + lane * 16 + 4 * c4) * (1.0f / ROWS_SCALE);
                const f32x4 g1v = *(const f32x4*)(MOD + bb * 6144 + 2048 + lane * 16 + 4 * c4);
                const f32x4 yf = {__uint_as_float(yw[2 * c4] << 16), __uint_as_float(yw[2 * c4] & 0xffff0000u), __uint_as_float(yw[2 * c4 + 1] << 16), __uint_as_float(yw[2 * c4 + 1] & 0xffff0000u)};
                x[q][c4] = x[q][c4] + g1v * yf + g * (f32x4){s[4 * c4], s[4 * c4 + 1], s[4 * c4 + 2], s[4 * c4 + 3]};
                *(f32x4*)(xw + 4 * c4) = x[q][c4];
                ss += x[q][c4].x * x[q][c4].x + x[q][c4].y * x[q][c4].y + x[q][c4].z * x[q][c4].z + x[q][c4].w * x[q][c4].w; }
            if (l == 0) {
                ss = wave_sum(ss);
                const float inv = rsqrtf(ss * (1.0f / D) + EPS);
                const int c = lane * 16; float h[16];
#pragma unroll
                for (int c4 = 0; c4 < 4; ++c4) { const f32x4 g = *(const f32x4*)(gn1 + c + 4 * c4), s1 = *(const f32x4*)(MOD1 + bb * 6144 + 1024 + c + 4 * c4), s0 = *(const f32x4*)(MOD1 + bb * 6144 + c + 4 * c4);
                    const f32x4 hv = x[q][c4] * inv * g * (1.0f + s1) + s0; h[4 * c4] = hv.x; h[4 * c4 + 1] = hv.y; h[4 * c4 + 2] = hv.z; h[4 * c4 + 3] = hv.w; }
                uint4 w0, w1;
                w0.x = pg8::cvt_pk_bf16(h[0], h[1]); w0.y = pg8::cvt_pk_bf16(h[2], h[3]); w0.z = pg8::cvt_pk_bf16(h[4], h[5]); w0.w = pg8::cvt_pk_bf16(h[6], h[7]);
                w1.x = pg8::cvt_pk_bf16(h[8], h[9]); w1.y = pg8::cvt_pk_bf16(h[10], h[11]); w1.z = pg8::cvt_pk_bf16(h[12], h[13]); w1.w = pg8::cvt_pk_bf16(h[14], h[15]);
                *(uint4*)(HB + (size_t)r * D + c) = w0; *(uint4*)(HB + (size_t)r * D + c + 8) = w1;
            }
        } }
    }
}

__device__ __forceinline__ void phase_combine(KP p, int l) {
    const int tid = opaque_tid(), lane = tid & 63, gw = blockIdx.x * NWAVES + (tid >> 6), NGW = gridDim.x * NWAVES;
    const bf16_t* ROWS = (const bf16_t*)(p->ws + WS_ROWS);
    const float* MOD = (const float*)(p->ws + WS_MOD) + (size_t)l * 9 * 6144;
    const int nrows = (l == 0) ? RT : RL;
    for (int r = gw; r < nrows; r += NGW) {
        const int bb = row_bb(r); float* xw = xw_row(p, r);
#pragma unroll
        for (int j = 0; j < 4; ++j) {
            const int c = lane * 4 + 256 * j; float s0 = 0.f, s1 = 0.f, s2 = 0.f, s3 = 0.f;
#pragma unroll
            for (int k = 0; k < 8; ++k) { const uint2 w = *(const uint2*)(ROWS + ((size_t)r * 8 + k) * D + c);
                s0 += __uint_as_float(w.x << 16); s1 += __uint_as_float(w.x & 0xffff0000u); s2 += __uint_as_float(w.y << 16); s3 += __uint_as_float(w.y & 0xffff0000u); }
            const f32x4 g = *(const f32x4*)(MOD + bb * 6144 + 5120 + c); f32x4 x = *(const f32x4*)(xw + c);
            x.x += g.x * s0; x.y += g.y * s1; x.z += g.z * s2; x.w += g.w * s3;
            *(f32x4*)(xw + c) = x;
        }
    }
}

constexpr int LDS_BYTES = 147456;
__global__ void __launch_bounds__(NTHREADS, 2) mega_fwd(Params pv) {
    KP p = (KP)__builtin_amdgcn_kernarg_segment_ptr();
    extern __shared__ __attribute__((aligned(16))) unsigned char lds[];
    LAS float* sm = (LAS float*)lds;
    volatile LAS unsigned* misc = (volatile LAS unsigned*)(lds + LDS_BYTES - 64);
    if (threadIdx.x < 16) misc[threadIdx.x] = 0u;
    __syncthreads();
    (void)xcd_barrier_post((unsigned*)(pv.ws + WS_CTL) + CW_BAR, misc);
#define GRID_BAR() do { XcdBarrier b_; b_.bar = (unsigned*)(p->ws + WS_CTL) + CW_BAR; b_.x = xb_xcc_id(); b_.st = misc; xcd_barrier(b_); } while (0)
    phase_convert(p, (LAS unsigned char*)lds, 240, 0, 0);
    phase_mod(p, sm);
    GRID_BAR();
#define LAYER(l) do { \
        if (l == 0) { phase_norm1(p, l); GRID_BAR(); } \
        phase_inproj_fast(p, l, (LAS unsigned char*)lds); GRID_BAR(); \
        phase_gmlp_fast(p, l, (char*)lds); phase_mixers(p, l, sm, false); GRID_BAR(); \
        phase_attn_fast(p, l, (char*)lds); GRID_BAR(); \
        phase_outproj_fast(p, l, (LAS unsigned char*)lds); GRID_BAR(); \
        phase_router_fast(p, l, (char*)lds); { const int tq_ = opaque_tid(); convert_queue(p, (LAS unsigned char*)lds, l, -1, tq_); } GRID_BAR(); \
        phase_moe_up_fast(p, l, (LAS unsigned char*)lds); GRID_BAR(); \
        phase_moe_down_ws(p, l, (LAS char*)lds); GRID_BAR(); \
        phase_combine_fast(p, l); if (l == 0) GRID_BAR(); } while (0)
    LAYER(0);
    LAYER(1);
#undef LAYER
}

extern "C" void kernel_launch(void* const* d_in, const int* in_sizes, int n_in, void* d_out, int out_size, void* d_ws, size_t ws_size, hipStream_t stream) {
    static int grid = 0;
    if (grid == 0) {
        if (n_in != 29 || out_size != RL * D || ws_size < WS_END) { fprintf(stderr, "kernel_launch: unexpected shapes n_in %d out %d ws %zu\n", n_in, out_size, ws_size); grid = -1; return; }
        int dev = 0, cus = 0, per_cu = 0;
        if (hipGetDevice(&dev) != hipSuccess || hipDeviceGetAttribute(&cus, hipDeviceAttributeMultiprocessorCount, dev) != hipSuccess) { grid = -1; return; }
        if (hipFuncSetAttribute((const void*)mega_fwd, hipFuncAttributeMaxDynamicSharedMemorySize, LDS_BYTES) != hipSuccess) { grid = -1; return; }
        if (hipOccupancyMaxActiveBlocksPerMultiprocessor(&per_cu, (const void*)mega_fwd, NTHREADS, LDS_BYTES) != hipSuccess || per_cu < 1) { fprintf(stderr, "occupancy query: %d\n", per_cu); }
        (void)hipGetLastError();
        grid = cus;
    }
    if (grid < 0) return;
    if (hipMemsetAsync((char*)d_ws + WS_CTL, 0, CTL_ZERO_BYTES, stream) != hipSuccess) return;
    Params p{};
    for (int i = 0; i < 29; ++i) p.in[i] = (const float*)d_in[i];
    p.out = (float*)d_out; p.ws = (unsigned char*)d_ws;
    hipLaunchKernelGGL(mega_fwd, dim3(grid), dim3(NTHREADS), LDS_BYTES, stream, p);
}
```

```cpp
#include <hip/hip_runtime.h>
#include <cstdio>
#include <cstdint>

#define LAS __attribute__((address_space(3)))
typedef unsigned short bf16_t;
typedef float f32x4 __attribute__((ext_vector_type(4)));

constexpr int D = 1024, NB = 8, SEQ = 2048, CTXL = 256;
constexpr int RL = NB * SEQ, RC = NB * CTXL, RT = RL + RC;
constexpr int DIN = 2816, OFF_AU = 0, OFF_AV = 256, OFF_BB = 512, OFF_BC = 768, OFF_BX = 1024, OFF_Q = 1280, OFF_K = 1792, OFF_V = 2304;
constexpr int NE = 64, TOPK = 8, DE = 256;
constexpr float EPS = 1e-6f;
constexpr int NTHREADS = 512, NWAVES = 8;

constexpr size_t MiB = 1u << 20;
constexpr size_t WS_CTL = 0, CTL_ZERO_BYTES = 1 * MiB;
constexpr size_t WS_MOD = 1 * MiB;
constexpr size_t WS_XC = 2 * MiB;
constexpr size_t WS_LIST = 10 * MiB;
constexpr size_t WS_WIN = 20 * MiB;
constexpr size_t WS_WOUT = 31 * MiB;
constexpr size_t WS_WR = 35 * MiB;
constexpr size_t WS_WSB = 35 * MiB + 512 * 1024;
constexpr size_t WS_WEXP = 36 * MiB;
constexpr size_t WEXP_STRIDE = 1572864, WEXP_DOWN = 1048576, WEXP_LAYER = 98 * MiB;
constexpr size_t WS_HID = 232 * MiB;
constexpr size_t WS_Y = 280 * MiB;
constexpr size_t WS_HB = 322 * MiB;
constexpr size_t WS_ROWS = 358 * MiB;
constexpr size_t WS_PB = 358 * MiB;
constexpr size_t WS_MIX = 457 * MiB;
constexpr size_t WS_X1B = WS_WEXP;
constexpr size_t WS_END = 520 * MiB;
constexpr float ROWS_SCALE = 8.0f;
constexpr int HID_SHARED_BASE = 163840;
constexpr int ROPE_OFF = 2 * 9 * 6144 + 64;
constexpr int CW_BAR = 4096;
constexpr int CW_CNT = 16384;
constexpr int CW_CVT = 20480;

#define XB_TMO      128
#define XB_XCNT(j)  (256  + 64 * (j))
#define XB_XSUB(j)  (1280 + 64 * (j))
#define XB_XGEN(j)  (2304 + 64 * (j))
#define XB_TOP      3328
#define XB_TOPGEN   3392
#define XCD_BAR_WORDS 3456
#define XB_SPIN_CAP (1u << 18)
__device__ __forceinline__ unsigned xb_ld(unsigned* p)              { return __hip_atomic_load(p, __ATOMIC_RELAXED, __HIP_MEMORY_SCOPE_AGENT); }
__device__ __forceinline__ unsigned xb_add(unsigned* p, unsigned v) { return __hip_atomic_fetch_add(p, v, __ATOMIC_RELAXED, __HIP_MEMORY_SCOPE_AGENT); }
__device__ __forceinline__ unsigned xb_xcc_id() { return (unsigned)__builtin_amdgcn_s_getreg((3 << 11) | 20) & 0xFu; }
#define XB_SPIN(cond, bar) do { unsigned _sp = 0; while (cond) { __builtin_amdgcn_s_sleep(1); \
    if ((++_sp & 255u) == 0u) { if (xb_ld(&(bar)[XB_TMO])) break; if (_sp > XB_SPIN_CAP) { atomicAdd(&(bar)[XB_TMO], 1u); break; } } } } while (0)
struct XcdBarrier { unsigned* bar; unsigned x; volatile LAS unsigned* st; };
__device__ __forceinline__ XcdBarrier xcd_barrier_post(unsigned* bar, volatile LAS unsigned* st) {
    XcdBarrier b; b.bar = bar; b.x = xb_xcc_id(); b.st = st;
    if (threadIdx.x == 0) (void)xb_add(&bar[XB_XCNT(b.x)], 1u);
    return b;
}
__device__ __forceinline__ void xcd_barrier_complete(unsigned* bar, unsigned x, unsigned& nloc, unsigned& nx) {
    const unsigned G = gridDim.x * gridDim.y * gridDim.z;
    unsigned sum, cnt, mine, sp = 0u;
    for (;;) {
        sum = 0u; cnt = 0u; mine = 0u;
#pragma unroll
        for (unsigned j = 0; j < 16; ++j) { const unsigned c = xb_ld(&bar[XB_XCNT(j)]); sum += c; cnt += (c > 0u) ? 1u : 0u; mine = (j == x) ? c : mine; }
        if (sum == G) break;
        __builtin_amdgcn_s_sleep(1);
        if ((++sp & 255u) == 0u) { if (xb_ld(&bar[XB_TMO])) break; if (sp > XB_SPIN_CAP) { atomicAdd(&bar[XB_TMO], 1u); break; } }
    }
    nloc = mine > 0u ? mine : 1u; nx = cnt > 0u ? cnt : 1u;
}
__device__ __forceinline__ void xcd_barrier(const XcdBarrier& b) {
    asm volatile("s_waitcnt vmcnt(0)" ::: "memory");
    __syncthreads();
    if (threadIdx.x == 0) {
        unsigned* bar = b.bar;
        __builtin_amdgcn_s_waitcnt(0);
        unsigned nloc = b.st[0], nx = b.st[1];
        if (nloc == 0u) { xcd_barrier_complete(bar, b.x, nloc, nx); b.st[0] = nloc; b.st[1] = nx; }
        const unsigned old = xb_add(&bar[XB_XSUB(b.x)], 1u);
        const unsigned gen = old / nloc;
        if (old + 1u == (gen + 1u) * nloc) {
            __builtin_amdgcn_fence(__ATOMIC_RELEASE, "agent");
            asm volatile("s_waitcnt vmcnt(0)" ::: "memory");
            const unsigned og = xb_add(&bar[XB_TOP], 1u);
            const unsigned tg = og / nx;
            if (og + 1u == (tg + 1u) * nx) xb_add(&bar[XB_TOPGEN], 1u);
            else XB_SPIN(xb_ld(&bar[XB_TOPGEN]) == tg, bar);
            __builtin_amdgcn_fence(__ATOMIC_ACQUIRE, "agent");
            xb_add(&bar[XB_XGEN(b.x)], 1u);
            asm volatile("s_waitcnt vmcnt(0)" ::: "memory");
        } else {
            XB_SPIN(xb_ld(&bar[XB_XGEN(b.x)]) == gen, bar);
            __builtin_amdgcn_fence(__ATOMIC_ACQUIRE, "agent");
            asm volatile("s_waitcnt vmcnt(0)" ::: "memory");
        }
    }
    __syncthreads();
}

__device__ __forceinline__ float bf2f(bf16_t v) { return __uint_as_float(((unsigned)v) << 16); }
__device__ __forceinline__ bf16_t f2bf(float f) { unsigned u = __float_as_uint(f); u += 0x7fffu + ((u >> 16) & 1u); return (bf16_t)(u >> 16); }
__device__ __forceinline__ float wave_sum(float v) {
#pragma unroll
    for (int o = 1; o < 64; o <<= 1) v += __shfl_xor(v, o);
    return v;
}
__device__ __forceinline__ float wave_max(float v) {
#pragma unroll
    for (int o = 1; o < 64; o <<= 1) v = fmaxf(v, __shfl_xor(v, o));
    return v;
}
__device__ __forceinline__ float gelu_exact(float v) { return 0.5f * v * (1.0f + erff(v * 0.70710678118654752f)); }
__device__ __forceinline__ float silu_f(float v) { return v / (1.0f + __expf(-v)); }

template <int S> __device__ __forceinline__ float sat8(float x) { return __builtin_amdgcn_fmed3f(x * (float)(S / 112.0), -4.0f, 4.0f) * 112.0f; }
__device__ __forceinline__ unsigned mix8_4(float a, float b, float c, float d) { int w = 0; w = __builtin_amdgcn_cvt_pk_fp8_f32(sat8<8>(a), sat8<8>(b), w, false); w = __builtin_amdgcn_cvt_pk_fp8_f32(sat8<8>(c), sat8<8>(d), w, true); return (unsigned)w; }
__device__ __forceinline__ unsigned char mix8_1(float a) { return (unsigned char)(__builtin_amdgcn_cvt_pk_fp8_f32(sat8<8>(a), 0.0f, 0, false) & 0xff); }
__device__ __forceinline__ int opaque_tid() { int t = threadIdx.x; asm volatile("" : "+v"(t)); return t; }
struct Params {
    const float* in[29];
    float* out;
    unsigned char* ws;
};
typedef const __attribute__((address_space(4))) Params* KP;
enum { I_X = 0, I_C, I_CTX, I_CCTX, I_WADA, I_BADA, I_GN1, I_GN2, I_WIN, I_WOUT, I_GV, I_WS, I_BS, I_WCONV, I_GQ, I_GK, I_LQ1, I_LK1, I_LQ2, I_LK2, I_GSUB,
       I_WROUTER, I_BROUTER, I_WGATE, I_WUP, I_WDOWN, I_SGATE, I_SUP, I_SDOWN };

__device__ __forceinline__ int row_bb(int r) { return r < RL ? (r / SEQ) : 8; }

constexpr int SG_BM = 128, SG_BN = 128, SG_BK = 16;
template <bool A_BF16, bool DUAL>
__device__ __forceinline__ void sgemm_tile(LAS float* sm, const void* Abase, int lda, const LAS int* rowidx, const float* B, const float* B2, int ldb, int n0, int K,
                                           float (&acc)[4][8], float (&acc2)[4][8], const int tid) {
    LAS float* As = sm;
    LAS float* Bs = sm + 16 * 132;
    LAS float* Bs2 = Bs + 16 * 128;
    const int ty = tid >> 4, tx = tid & 15;
#pragma unroll
    for (int i = 0; i < 4; ++i)
#pragma unroll
        for (int j = 0; j < 8; ++j) { acc[i][j] = 0.f; acc2[i][j] = 0.f; }
    const int am = tid >> 2, ak = (tid & 3) * 4;
    const int arow = rowidx[am];
    const int bk = tid >> 5, bn = (tid & 31) * 4;
    for (int k0 = 0; k0 < K; k0 += SG_BK) {
        float a0 = 0.f, a1 = 0.f, a2 = 0.f, a3 = 0.f;
        if (arow >= 0) {
            if (A_BF16) { const bf16_t* ap = (const bf16_t*)Abase + (size_t)arow * lda + k0 + ak; const uint2 w = *(const uint2*)ap;
                a0 = __uint_as_float(w.x << 16); a1 = __uint_as_float(w.x & 0xffff0000u); a2 = __uint_as_float(w.y << 16); a3 = __uint_as_float(w.y & 0xffff0000u); }
            else { const float* ap = (const float*)Abase + (size_t)arow * lda + k0 + ak; const f32x4 w = *(const f32x4*)ap; a0 = w.x; a1 = w.y; a2 = w.z; a3 = w.w; }
        }
        const f32x4 bv = *(const f32x4*)(B + (size_t)(k0 + bk) * ldb + n0 + bn);
        f32x4 bv2 = {0.f, 0.f, 0.f, 0.f};
        if (DUAL) bv2 = *(const f32x4*)(B2 + (size_t)(k0 + bk) * ldb + n0 + bn);
        __syncthreads();
        As[(ak + 0) * 132 + am] = a0; As[(ak + 1) * 132 + am] = a1; As[(ak + 2) * 132 + am] = a2; As[(ak + 3) * 132 + am] = a3;
        *(LAS f32x4*)(Bs + bk * 128 + bn) = bv;
        if (DUAL) *(LAS f32x4*)(Bs2 + bk * 128 + bn) = bv2;
        __syncthreads();
#pragma unroll
        for (int k = 0; k < SG_BK; ++k) {
            const f32x4 av = *(const LAS f32x4*)(As + k * 132 + ty * 4);
            const f32x4 b0 = *(const LAS f32x4*)(Bs + k * 128 + tx * 8), b1 = *(const LAS f32x4*)(Bs + k * 128 + tx * 8 + 4);
            const float a[4] = {av.x, av.y, av.z, av.w}; const float b[8] = {b0.x, b0.y, b0.z, b0.w, b1.x, b1.y, b1.z, b1.w};
#pragma unroll
            for (int i = 0; i < 4; ++i)
#pragma unroll
                for (int j = 0; j < 8; ++j) acc[i][j] = fmaf(a[i], b[j], acc[i][j]);
            if (DUAL) {
                const f32x4 c0 = *(const LAS f32x4*)(Bs2 + k * 128 + tx * 8), c1 = *(const LAS f32x4*)(Bs2 + k * 128 + tx * 8 + 4);
                const float c[8] = {c0.x, c0.y, c0.z, c0.w, c1.x, c1.y, c1.z, c1.w};
#pragma unroll
                for (int i = 0; i < 4; ++i)
#pragma unroll
                    for (int j = 0; j < 8; ++j) acc2[i][j] = fmaf(a[i], c[j], acc2[i][j]);
            }
        }
    }
    __syncthreads();
}

__device__ __forceinline__ void phase_mod(KP p, LAS float* sm) {
    const int tid = opaque_tid(), lane = tid & 63, wave = tid >> 6;
    float* MOD = (float*)(p->ws + WS_MOD);
    LAS float* sc = sm;
    LAS float* red = sm + 9 * 1024;
    for (int i = tid; i < 9 * 1024; i += NTHREADS) { const int bb = i >> 10, k = i & 1023; const float v = bb < 8 ? p->in[I_C][bb * D + k] : p->in[I_CCTX][k]; sc[i] = silu_f(v); }
    __syncthreads();
    for (int u = blockIdx.x; u < 2 * 96; u += gridDim.x) {
        const int l = u / 96, j0 = (u % 96) * 64;
        const float* W = p->in[I_WADA] + (size_t)l * D * 6144;
        float acc[9];
#pragma unroll
        for (int b = 0; b < 9; ++b) acc[b] = 0.f;
        for (int k0 = wave * 128; k0 < wave * 128 + 128; k0 += 16) {
            float wv[16];
#pragma unroll
            for (int q = 0; q < 16; ++q) wv[q] = __builtin_nontemporal_load(W + (size_t)(k0 + q) * 6144 + j0 + lane);
#pragma unroll
            for (int q = 0; q < 16; ++q)
#pragma unroll
                for (int b = 0; b < 9; ++b) acc[b] = fmaf(sc[b * 1024 + k0 + q], wv[q], acc[b]);
        }
#pragma unroll
        for (int b = 0; b < 9; ++b) red[(wave * 9 + b) * 64 + lane] = acc[b];
        __syncthreads();
        for (int i = tid; i < 9 * 64; i += NTHREADS) { const int b = i >> 6, c = i & 63; float s = 0.f;
#pragma unroll
            for (int w = 0; w < 8; ++w) s += red[(w * 9 + b) * 64 + c];
            MOD[((size_t)l * 9 + b) * 6144 + j0 + c] = s + p->in[I_BADA][l * 6144 + j0 + c]; }
        __syncthreads();
    }
    {
        bf16_t* WRT = (bf16_t*)(p->ws + WS_WR); bf16_t* WSB = (bf16_t*)(p->ws + WS_WSB);
        for (int i = blockIdx.x * NTHREADS + tid; i < 2 * 64 * 1024; i += gridDim.x * NTHREADS) {
            const int ll = i >> 16, ii = i & 65535, j = ii & 7, ln = (ii >> 3) & 63, s = (ii >> 9) & 15, kq = (ii >> 13) & 3, nt = ii >> 15;
            const int e = nt * 32 + (ln & 31), k = kq * 256 + s * 16 + (ln >> 5) * 8 + j;
            WRT[i] = f2bf(p->in[I_WROUTER][((size_t)ll * D + k) * NE + e]);
            WSB[i] = f2bf(p->in[I_WS][i]);
        }
    }
    {
        for (int i = blockIdx.x * NTHREADS + tid; i < 64 * 16; i += gridDim.x * NTHREADS) { const int pos = i >> 4, f = i & 15;
            const float invf = powf(10000.0f, -(float)f / 16.0f); const float ang = (float)pos * invf;
            MOD[ROPE_OFF + pos * 32 + f] = cosf(ang); MOD[ROPE_OFF + pos * 32 + 16 + f] = sinf(ang); }
    }
    if (blockIdx.x == 0 && wave == 0) {
        for (int l = 0; l < 2; ++l) {
            const float a = wave_sum(p->in[I_LQ1][l * 64 + lane] * p->in[I_LK1][l * 64 + lane]);
            const float b = wave_sum(p->in[I_LQ2][l * 64 + lane] * p->in[I_LK2][l * 64 + lane]);
            const float lam_init = 0.8f - 0.6f * expf(-0.3f * (float)l);
            if (lane == 0) MOD[2 * 9 * 6144 + l] = expf(a) - expf(b) + lam_init;
        }
    }
}

__device__ __forceinline__ const float* xsrc_row(KP p, int l, int r) {
    if (l == 0) return r < RL ? p->in[I_X] + (size_t)r * D : p->in[I_CTX] + (size_t)(r - RL) * D;
    return r < RL ? p->out + (size_t)r * D : (const float*)(p->ws + WS_XC) + (size_t)(r - RL) * D;
}
__device__ __forceinline__ float* xw_row(KP p, int r) {
    return r < RL ? p->out + (size_t)r * D : (float*)(p->ws + WS_XC) + (size_t)(r - RL) * D;
}

__device__ __forceinline__ void norm_row(const float* src, const float* gn, const float* scv, const float* shv, bf16_t* dst, int lane, float (&hv)[16]) {
    f32x4 v[4]; float ss = 0.f;
#pragma unroll
    for (int j = 0; j < 4; ++j) { v[j] = *(const f32x4*)(src + lane * 4 + 256 * j); ss += v[j].x * v[j].x + v[j].y * v[j].y + v[j].z * v[j].z + v[j].w * v[j].w; }
    ss = wave_sum(ss);
    const float inv = rsqrtf(ss * (1.0f / D) + EPS);
#pragma unroll
    for (int j = 0; j < 4; ++j) {
        const int c = lane * 4 + 256 * j;
        const f32x4 g = *(const f32x4*)(gn + c), s1 = *(const f32x4*)(scv + c), s0 = *(const f32x4*)(shv + c);
        const float h0 = v[j].x * inv * g.x * (1.f + s1.x) + s0.x, h1 = v[j].y * inv * g.y * (1.f + s1.y) + s0.y;
        const float h2 = v[j].z * inv * g.z * (1.f + s1.z) + s0.z, h3 = v[j].w * inv * g.w * (1.f + s1.w) + s0.w;
        hv[4 * j + 0] = h0; hv[4 * j + 1] = h1; hv[4 * j + 2] = h2; hv[4 * j + 3] = h3;
        uint2 w; w.x = (unsigned)f2bf(h0) | ((unsigned)f2bf(h1) << 16); w.y = (unsigned)f2bf(h2) | ((unsigned)f2bf(h3) << 16);
        *(uint2*)(dst + c) = w;
    }
}
__device__ __forceinline__ void phase_norm1(KP p, int l) {
    const int tid = opaque_tid(), lane = tid & 63, gw = blockIdx.x * NWAVES + (tid >> 6), NGW = gridDim.x * NWAVES;
    const float* MOD = (const float*)(p->ws + WS_MOD) + (size_t)l * 9 * 6144;
    bf16_t* HB = (bf16_t*)(p->ws + WS_HB);
    const float* gn = p->in[I_GN1] + l * D;
    for (int r0 = gw; r0 < RT; r0 += 3 * NGW) {
        f32x4 v[3][4];
#pragma unroll
        for (int q = 0; q < 3; ++q) { const int r = r0 + q * NGW; if (r < RT) { const float* s = xsrc_row(p, l, r) + lane * 4;
#pragma unroll
            for (int j = 0; j < 4; ++j) v[q][j] = __builtin_nontemporal_load((const f32x4*)(s + 256 * j)); } }
#pragma unroll
        for (int q = 0; q < 3; ++q) { const int r = r0 + q * NGW; if (r < RT) {
            const int bb = row_bb(r); float ss = 0.f;
#pragma unroll
            for (int j = 0; j < 4; ++j) ss += v[q][j].x * v[q][j].x + v[q][j].y * v[q][j].y + v[q][j].z * v[q][j].z + v[q][j].w * v[q][j].w;
            ss = wave_sum(ss);
            const float inv = rsqrtf(ss * (1.0f / D) + EPS);
#pragma unroll
            for (int j = 0; j < 4; ++j) { const int c = lane * 4 + 256 * j;
                const f32x4 g = *(const f32x4*)(gn + c), s1 = *(const f32x4*)(MOD + bb * 6144 + 1024 + c), s0 = *(const f32x4*)(MOD + bb * 6144 + c);
                const f32x4 h = v[q][j] * inv * g * (1.0f + s1) + s0;
                int w8 = 0; w8 = __builtin_amdgcn_cvt_pk_fp8_f32(sat8<16>(h.x), sat8<16>(h.y), w8, false); w8 = __builtin_amdgcn_cvt_pk_fp8_f32(sat8<16>(h.z), sat8<16>(h.w), w8, true);
                *(int*)((unsigned char*)HB + (size_t)r * D + c) = w8; }
        } }
    }
}

__device__ __forceinline__ void phase_inproj(KP p, int l, LAS float* sm) {
    const int tid = opaque_tid(), ty = tid >> 4, tx = tid & 15;
    LAS int* rowidx = (LAS int*)(sm + 16 * 132 + 2 * 16 * 128);
    const bf16_t* HB = (const bf16_t*)(p->ws + WS_HB); bf16_t* PB = (bf16_t*)(p->ws + WS_PB);
    const float* W = p->in[I_WIN] + (size_t)l * D * DIN;
    const int nMt = RT / 128, nNt = DIN / 128;
    for (int u = blockIdx.x; u < nMt * nNt; u += gridDim.x) {
        const int mt = u / nNt, nt = u % nNt;
        if (tid < 128) rowidx[tid] = mt * 128 + tid;
        __syncthreads();
        float acc[4][8], acc2[4][8];
        sgemm_tile<true, false>(sm, HB, D, rowidx, W, nullptr, DIN, nt * 128, D, acc, acc2, tid);
#pragma unroll
        for (int i = 0; i < 4; ++i) { const int r = mt * 128 + ty * 4 + i;
#pragma unroll
            for (int j = 0; j < 8; ++j) { const int c = nt * 128 + tx * 8 + j; float v = acc[i][j]; if (c < 512) v = gelu_exact(v); PB[(size_t)r * DIN + c] = f2bf(v); } }
    }
}

__device__ __forceinline__ void phase_mixers(KP p, int l, LAS float* sm, const bool do_gmlp) {
    const int tid = opaque_tid(), lane = tid & 63, wave = tid >> 6;
    bf16_t* PB = (bf16_t*)(p->ws + WS_PB); unsigned char* MIX = (unsigned char*)(p->ws + WS_MIX);
    if (do_gmlp) {
        LAS float* vn = sm;
        LAS float* wsm = sm + 128 * 64;
        LAS float* rinv = wsm + 128 * 129;
        const int nchunks = (l == 0 ? RT : RL) / 128;
        const float* gv = p->in[I_GV] + l * 256;
        for (int u = blockIdx.x; u < nchunks * 4; u += gridDim.x) {
            const int ch = u >> 2, g = u & 3, r0 = ch * 128;
            for (int q = wave * 16; q < wave * 16 + 16; ++q) {
                const bf16_t* vr = PB + (size_t)(r0 + q) * DIN + OFF_AV + lane * 4;
                const uint2 w = *(const uint2*)vr;
                const float a = __uint_as_float(w.x << 16), b = __uint_as_float(w.x & 0xffff0000u), c = __uint_as_float(w.y << 16), d = __uint_as_float(w.y & 0xffff0000u);
                const float ss = wave_sum(a * a + b * b + c * c + d * d);
                if (lane == 0) rinv[q] = rsqrtf(ss * (1.0f / 256.0f) + EPS);
            }
            const float* wsrc = p->in[I_WS] + ((size_t)l * 4 + g) * 128 * 128;
            for (int i = tid; i < 128 * 128; i += NTHREADS) wsm[(i >> 7) * 129 + (i & 127)] = wsrc[i];
            __syncthreads();
            for (int i = tid; i < 128 * 64; i += NTHREADS) { const int q = i >> 6, d = i & 63;
                vn[i] = bf2f(PB[(size_t)(r0 + q) * DIN + OFF_AV + g * 64 + d]) * rinv[q] * gv[g * 64 + d]; }
            __syncthreads();
            const int pp = tid >> 2, d0 = (tid & 3) * 16;
            float acc[16];
#pragma unroll
            for (int i = 0; i < 16; ++i) acc[i] = 0.f;
            for (int q = 0; q < 128; ++q) {
                const float w = wsm[pp * 129 + q];
#pragma unroll
                for (int i4 = 0; i4 < 4; ++i4) { const f32x4 x = *(const LAS f32x4*)(vn + q * 64 + d0 + i4 * 4);
                    acc[i4 * 4 + 0] = fmaf(w, x.x, acc[i4 * 4 + 0]); acc[i4 * 4 + 1] = fmaf(w, x.y, acc[i4 * 4 + 1]); acc[i4 * 4 + 2] = fmaf(w, x.z, acc[i4 * 4 + 2]); acc[i4 * 4 + 3] = fmaf(w, x.w, acc[i4 * 4 + 3]); }
            }
            const float bias = p->in[I_BS][(l * 4 + g) * 128 + pp];
#pragma unroll
            for (int i = 0; i < 16; ++i) { const int c = g * 64 + d0 + i; const float uu = bf2f(PB[(size_t)(r0 + pp) * DIN + OFF_AU + c]);
                MIX[(size_t)(r0 + pp) * D + c] = mix8_1(uu * (acc[i] + bias)); }
            __syncthreads();
        }
    }
    {
        const int nchk = (l == 0 ? RT : RL) / 128, W1 = (l == 0 ? 44 : 40), W2 = (RT - nchk * W1 + (int)gridDim.x - nchk - 1) / ((int)gridDim.x - nchk);
        const int rb = (int)blockIdx.x < nchk ? (int)blockIdx.x * W1 : nchk * W1 + ((int)blockIdx.x - nchk) * W2;
        const int re_ = rb + ((int)blockIdx.x < nchk ? W1 : W2), re = re_ < RT ? re_ : RT;
        const int gw = rb + wave; constexpr int NGW = NWAVES;
        const float* wc = p->in[I_WCONV] + l * 3 * 256;
        const float* gq = p->in[I_GQ] + l * 64; const float* gk = p->in[I_GK] + l * 64;
        const float* ROPE = (const float*)(p->ws + WS_MOD) + ROPE_OFF;
        const int c = lane * 4, vid = lane >> 2, qt = lane & 3;
        const float* gg = vid < 8 ? gq : gk;
        constexpr int NR = 3;
        for (int r0 = gw; r0 < re; r0 += NR * NGW) {
            uint2 cgv[NR][3], xiv[NR][3], bgv[NR]; uint4 qk0[NR], qk1[NR];
#pragma unroll
            for (int q = 0; q < NR; ++q) { const int r = r0 + q * NGW; if (r < re) {
                const bool lat = r < RL; const int t = lat ? (r % SEQ) : ((r - RL) % CTXL); const int slen = lat ? SEQ : CTXL;
#pragma unroll
                for (int d = 0; d < 3; ++d) { const int rr = (t + d - 1 >= 0 && t + d - 1 < slen) ? r + d - 1 : r; const bf16_t* rp = PB + (size_t)rr * DIN;
                    cgv[q][d] = *(const uint2*)(rp + OFF_BC + c); xiv[q][d] = *(const uint2*)(rp + OFF_BX + c); }
                bgv[q] = *(const uint2*)(PB + (size_t)r * DIN + OFF_BB + c);
                const bf16_t* vp = PB + (size_t)r * DIN + OFF_Q + vid * 64 + qt * 16;
                qk0[q] = *(const uint4*)vp; qk1[q] = *(const uint4*)(vp + 8); } }
#pragma unroll
            for (int q = 0; q < NR; ++q) { const int r = r0 + q * NGW; if (r < re) {
                const bool lat = r < RL; const int t = lat ? (r % SEQ) : ((r - RL) % CTXL); const int slen = lat ? SEQ : CTXL;
                if (lat || l == 0) {
                    float z[3][4];
#pragma unroll
                    for (int d = 0; d < 3; ++d) { const float ok = (t + d - 1 >= 0 && t + d - 1 < slen) ? 1.0f : 0.0f; const uint2 cg = cgv[q][d], xi = xiv[q][d];
                        z[d][0] = ok * __uint_as_float(cg.x << 16) * __uint_as_float(xi.x << 16); z[d][1] = ok * __uint_as_float(cg.x & 0xffff0000u) * __uint_as_float(xi.x & 0xffff0000u);
                        z[d][2] = ok * __uint_as_float(cg.y << 16) * __uint_as_float(xi.y << 16); z[d][3] = ok * __uint_as_float(cg.y & 0xffff0000u) * __uint_as_float(xi.y & 0xffff0000u); }
                    const uint2 bg = bgv[q];
                    const float bgf[4] = {__uint_as_float(bg.x << 16), __uint_as_float(bg.x & 0xffff0000u), __uint_as_float(bg.y << 16), __uint_as_float(bg.y & 0xffff0000u)};
                    float y[4];
#pragma unroll
                    for (int i = 0; i < 4; ++i) y[i] = bgf[i] * (wc[0 * 256 + c + i] * z[0][i] + wc[1 * 256 + c + i] * z[1][i] + wc[2 * 256 + c + i] * z[2][i]);
                    *(unsigned*)(MIX + (size_t)r * D + 256 + c) = mix8_4(y[0], y[1], y[2], y[3]);
                }
                {
                    bf16_t* vp = PB + (size_t)r * DIN + OFF_Q + vid * 64 + qt * 16;
                    const uint4 w0 = qk0[q], w1 = qk1[q];
                    const unsigned ww[8] = {w0.x, w0.y, w0.z, w0.w, w1.x, w1.y, w1.z, w1.w};
                    float e[16]; float ss = 0.f;
#pragma unroll
                    for (int i = 0; i < 8; ++i) { e[2 * i] = __uint_as_float(ww[i] << 16); e[2 * i + 1] = __uint_as_float(ww[i] & 0xffff0000u); ss += e[2 * i] * e[2 * i] + e[2 * i + 1] * e[2 * i + 1]; }
                    ss += __shfl_xor(ss, 1); ss += __shfl_xor(ss, 2);
                    const float inv = rsqrtf(ss * (1.0f / 64.0f) + EPS);
#pragma unroll
                    for (int i = 0; i < 16; ++i) e[i] = e[i] * inv * gg[qt * 16 + i];
                    if (lat) {
                        const int pos = (qt < 2) ? (t / 64) : (t % 64);
                        const float* rt = ROPE + pos * 32;
#pragma unroll
                        for (int i4 = 0; i4 < 4; ++i4) {
                            const f32x4 cs4 = *(const f32x4*)(rt + i4 * 4), sn4 = *(const f32x4*)(rt + 16 + i4 * 4);
                            const float csv[4] = {cs4.x, cs4.y, cs4.z, cs4.w}, snv[4] = {sn4.x, sn4.y, sn4.z, sn4.w};
#pragma unroll
                            for (int ii = 0; ii < 4; ++ii) { const int i = i4 * 4 + ii;
                                const float other = __shfl_xor(e[i], 1);
                                e[i] = (qt & 1) ? (e[i] * csv[ii] + other * snv[ii]) : (e[i] * csv[ii] - other * snv[ii]); }
                        }
                    }
                    uint4 o0, o1;
                    o0.x = (unsigned)f2bf(e[0]) | ((unsigned)f2bf(e[1]) << 16); o0.y = (unsigned)f2bf(e[2]) | ((unsigned)f2bf(e[3]) << 16);
                    o0.z = (unsigned)f2bf(e[4]) | ((unsigned)f2bf(e[5]) << 16); o0.w = (unsigned)f2bf(e[6]) | ((unsigned)f2bf(e[7]) << 16);
                    o1.x = (unsigned)f2bf(e[8]) | ((unsigned)f2bf(e[9]) << 16); o1.y = (unsigned)f2bf(e[10]) | ((unsigned)f2bf(e[11]) << 16);
                    o1.z = (unsigned)f2bf(e[12]) | ((unsigned)f2bf(e[13]) << 16); o1.w = (unsigned)f2bf(e[14]) | ((unsigned)f2bf(e[15]) << 16);
                    *(uint4*)vp = o0; *(uint4*)(vp + 8) = o1;
                }
            } }
        }
    }
}

namespace att {
using bf16x8 = __attribute__((ext_vector_type(8))) short;
using s16x4  = __attribute__((ext_vector_type(4))) short;
using f32x16 = __attribute__((ext_vector_type(16))) float;
using u32x4  = __attribute__((ext_vector_type(4))) unsigned;
constexpr int KVBLK = 64;
constexpr float SCALE = 0.125f;
constexpr float THR = 8.f;
constexpr int SHM_V = KVBLK * 128 * 2, SHM_K = KVBLK * 128 * 2;
#define KSWZ(row, colB) ((row) * 256 + ((colB) ^ (((row) & 7) << 4)))
#define SBAR() __builtin_amdgcn_sched_barrier(0)
__device__ __forceinline__ int crow(int r, int hi) { return (r & 3) + 8 * (r >> 2) + 4 * hi; }
__device__ __forceinline__ unsigned cvtpk(float lo, float hi) { unsigned r; asm volatile("v_cvt_pk_bf16_f32 %0, %1, %2" : "=v"(r) : "v"(lo), "v"(hi)); return r; }
__device__ __forceinline__ void partialSM(f32x16& p0, f32x16& p1, float& m_reg, float& mn, float& alpha) {
  constexpr float C = SCALE * 1.4426950408889634f;
  float pmax = p0[0]; for (int r = 1; r < 16; ++r) pmax = fmaxf(pmax, p0[r]); for (int r = 0; r < 16; ++r) pmax = fmaxf(pmax, p1[r]);
  { auto rr = __builtin_amdgcn_permlane32_swap(__float_as_uint(pmax), __float_as_uint(pmax), false, false);
    pmax = fmaxf(__uint_as_float(rr[0]), __uint_as_float(rr[1])); }
  if (__builtin_expect(__all(pmax - m_reg <= THR / SCALE), 1)) { mn = m_reg; alpha = 1.f; }
  else { mn = fmaxf(m_reg, pmax); alpha = __builtin_amdgcn_exp2f((m_reg - mn) * C); m_reg = mn; }
  float mnC = -mn * C;
  for (int r = 0; r < 16; ++r) p0[r] = fmaf(p0[r], C, mnC); for (int r = 0; r < 16; ++r) p1[r] = fmaf(p1[r], C, mnC);
  for (int r = 0; r < 16; ++r) p0[r] = __builtin_amdgcn_exp2f(p0[r]);
}
__device__ __forceinline__ void finishSM(f32x16& p0, f32x16& p1, float alpha, float& l_reg, bf16x8& pa0, bf16x8& pa1, bf16x8& pa2, bf16x8& pa3) {
  for (int r = 0; r < 16; ++r) p1[r] = __builtin_amdgcn_exp2f(p1[r]);
  float ps = 0; for (int r = 0; r < 16; ++r) ps += p0[r]; for (int r = 0; r < 16; ++r) ps += p1[r];
  { auto rr = __builtin_amdgcn_permlane32_swap(__float_as_uint(ps), __float_as_uint(ps), false, false);
    ps = __uint_as_float(rr[0]) + __uint_as_float(rr[1]); }
  l_reg = l_reg * alpha + ps;
#define PK4(P, BASE, OUT) do { unsigned a0 = cvtpk(P[BASE + 0], P[BASE + 1]), a1 = cvtpk(P[BASE + 2], P[BASE + 3]);   \
    unsigned b0 = cvtpk(P[BASE + 4], P[BASE + 5]), b1 = cvtpk(P[BASE + 6], P[BASE + 7]);                              \
    auto r0 = __builtin_amdgcn_permlane32_swap(a0, b0, false, false); auto r1 = __builtin_amdgcn_permlane32_swap(a1, b1, false, false); \
    u32x4 w = {r0[0], r1[0], r0[1], r1[1]}; OUT = *reinterpret_cast<bf16x8*>(&w); } while (0)
  PK4(p0, 0, pa0); PK4(p0, 8, pa1); PK4(p1, 0, pa2); PK4(p1, 8, pa3);
#undef PK4
}
__device__ __forceinline__ void qkt(f32x16& p0, f32x16& p1, const char* Ks, const bf16x8* qr, int r32, int hi, int hfB) {
  p0 = f32x16{}; p1 = f32x16{};
#pragma unroll
  for (int d0 = 0; d0 < 4; ++d0) { int cb = hfB + (d0 * 16 + hi * 8) * 2;
    bf16x8 b0 = *reinterpret_cast<const bf16x8*>(Ks + KSWZ(r32, cb));
    bf16x8 b1 = *reinterpret_cast<const bf16x8*>(Ks + KSWZ(32 + r32, cb));
    p0 = __builtin_amdgcn_mfma_f32_32x32x16_bf16(b0, qr[d0], p0, 0, 0, 0);
    p1 = __builtin_amdgcn_mfma_f32_32x32x16_bf16(b1, qr[d0], p1, 0, 0, 0); }
}
__device__ __forceinline__ int v_st(int k, int c) { const int kk = (k & ~0xC) | ((k & 4) << 1) | ((k & 8) >> 1); return ((kk >> 3) * 4 + (c >> 5)) * 512 + ((kk & 7) * 32 + (c & 31)) * 2; }
__device__ __forceinline__ int v_rd_base(int lane) { return ((lane & 3) << 3) | (((lane >> 2) & 3) << 6) | (((lane >> 4) & 1) << 5) | (((lane >> 5) & 1) << 8); }
constexpr int v_rd_off(int d0, int ks, int half) { return d0 * 512 + ks * 4096 + half * 2048; }
template <int OFF> __device__ __forceinline__ s16x4 tr_read(int vb) {
  s16x4 r; asm volatile("ds_read_b64_tr_b16 %0, %1 offset:%2" : "=&v"(r) : "v"(vb), "i"(OFF) : "memory"); return r;
}
template <int D0> __device__ __forceinline__ void pv_one(f32x16& od, int vb, bf16x8 pa0, bf16x8 pa1, bf16x8 pa2, bf16x8 pa3) {
  const s16x4 l0 = tr_read<v_rd_off(D0, 0, 0)>(vb), h0 = tr_read<v_rd_off(D0, 0, 1)>(vb), l1 = tr_read<v_rd_off(D0, 1, 0)>(vb), h1 = tr_read<v_rd_off(D0, 1, 1)>(vb);
  const s16x4 l2 = tr_read<v_rd_off(D0, 2, 0)>(vb), h2 = tr_read<v_rd_off(D0, 2, 1)>(vb), l3 = tr_read<v_rd_off(D0, 3, 0)>(vb), h3 = tr_read<v_rd_off(D0, 3, 1)>(vb);
  asm volatile("s_waitcnt lgkmcnt(0)" ::: "memory"); SBAR();
#define PK(L, H) (bf16x8){L[0], L[1], L[2], L[3], H[0], H[1], H[2], H[3]}
  od = __builtin_amdgcn_mfma_f32_32x32x16_bf16(pa0, PK(l0, h0), od, 0, 0, 0);
  od = __builtin_amdgcn_mfma_f32_32x32x16_bf16(pa1, PK(l1, h1), od, 0, 0, 0);
  od = __builtin_amdgcn_mfma_f32_32x32x16_bf16(pa2, PK(l2, h2), od, 0, 0, 0);
  od = __builtin_amdgcn_mfma_f32_32x32x16_bf16(pa3, PK(l3, h3), od, 0, 0, 0);
#undef PK
}
__device__ __forceinline__ void pv_d0(f32x16* o, int vb, bf16x8 pa0, bf16x8 pa1, bf16x8 pa2, bf16x8 pa3) {
  pv_one<0>(o[0], vb, pa0, pa1, pa2, pa3); pv_one<1>(o[1], vb, pa0, pa1, pa2, pa3); pv_one<2>(o[2], vb, pa0, pa1, pa2, pa3); pv_one<3>(o[3], vb, pa0, pa1, pa2, pa3);
}
__device__ __forceinline__ void attn_unit(const bf16_t* __restrict__ PB, unsigned char* __restrict__ MIX, int qrow0, int h, int cbase, int lbase, int NT,
                                          float lam, float onorm, const float* __restrict__ gsub, char* lds, const int tid) {
  const int wid = tid >> 6, lane = tid & 63, r32 = lane & 31, hi = lane >> 5, rg = wid & 3, hf = wid >> 2, hfB = hf * 128;
  char* V_lds = lds; char* K_lds = lds + 2 * SHM_V;
  float* wsl = (float*)(lds + 2 * SHM_V + 2 * SHM_K) + wid * 64; float* li_l = wsl; float* al_l = wsl + 32;
  float m_reg = -1e30f, l_reg = 0; f32x16 o[4] = {}; bf16x8 qr[4];
  const bf16_t* Qw = PB + (size_t)(qrow0 + rg * 32 + r32) * DIN + OFF_Q + hf * 256 + h * 64 + hi * 8;
#pragma unroll
  for (int d0 = 0; d0 < 4; ++d0) qr[d0] = *reinterpret_cast<const bf16x8*>(Qw + d0 * 16);
  const int sr = tid >> 4, sc = (tid & 15) * 8, vst0 = v_st(sr, sc), vst1 = v_st(32 + sr, sc);
  const int kcol = OFF_K + h * 64 + (sc < 64 ? sc : 256 + sc - 64), vcol = OFF_V + h * 128 + sc;
  const int vb0 = (int)(uintptr_t)V_lds + v_rd_base(lane);
  struct { bf16x8 vs0, vs1, ks0, ks1; } sr_[2];
#define TROW(k0) ((k0) < CTXL ? (cbase + (k0)) : (lbase + (k0) - CTXL))
#define SLOAD(i, k0) do { const bf16_t* rp_ = PB + (size_t)(TROW(k0) + sr) * DIN; \
    sr_[i].vs0 = *reinterpret_cast<const bf16x8*>(rp_ + vcol); sr_[i].vs1 = *reinterpret_cast<const bf16x8*>(rp_ + (size_t)32 * DIN + vcol); \
    sr_[i].ks0 = *reinterpret_cast<const bf16x8*>(rp_ + kcol); sr_[i].ks1 = *reinterpret_cast<const bf16x8*>(rp_ + (size_t)32 * DIN + kcol); } while (0)
#define SWRITE(b, i) do { *(bf16x8*)(V_lds + (b) * SHM_V + vst0) = sr_[i].vs0;          \
    *(bf16x8*)(V_lds + (b) * SHM_V + vst1) = sr_[i].vs1; int kc = sc * 2;               \
    *(bf16x8*)(K_lds + (b) * SHM_K + KSWZ(sr, kc)) = sr_[i].ks0;                       \
    *(bf16x8*)(K_lds + (b) * SHM_K + KSWZ(32 + sr, kc)) = sr_[i].ks1; } while (0)
#define SWAIT() asm volatile("s_waitcnt vmcnt(4)" ::: "memory")
#define RESC(a) do { if (__any((a) < 1.f)) { if (hi == 0) al_l[r32] = (a); asm volatile("s_waitcnt lgkmcnt(0)" ::: "memory"); \
    for (int d = 0; d < 4; ++d) for (int r = 0; r < 16; ++r) o[d][r] *= al_l[crow(r, hi)]; } } while (0)
  f32x16 pA0, pA1, pB0, pB1; float mnA, mnB, alA, alB; bf16x8 pa0, pa1, pa2, pa3;
  constexpr int SE = 0, SO = 1;
  SLOAD(SE, 0); asm volatile("s_waitcnt vmcnt(0)" ::: "memory"); SWRITE(0, SE); __syncthreads();
  qkt(pA0, pA1, K_lds, qr, r32, hi, hfB); partialSM(pA0, pA1, m_reg, mnA, alA);
  SLOAD(SO, KVBLK); if (2 < NT) SLOAD(SE, 2 * KVBLK);
  SWAIT(); SWRITE(1, SO); __syncthreads();
  for (int j = 1; j + 1 < NT; j += 2) {
    SBAR(); qkt(pB0, pB1, K_lds + SHM_K, qr, r32, hi, hfB);
    finishSM(pA0, pA1, alA, l_reg, pa0, pa1, pa2, pa3); SBAR();
    SLOAD(SO, (j + 2) * KVBLK); SBAR();
    pv_d0(o, vb0, pa0, pa1, pa2, pa3); partialSM(pB0, pB1, m_reg, mnB, alB);
    __syncthreads(); SWAIT(); SWRITE(0, SE);
    RESC(alB); __syncthreads();
    SBAR(); qkt(pA0, pA1, K_lds, qr, r32, hi, hfB);
    finishSM(pB0, pB1, alB, l_reg, pa0, pa1, pa2, pa3); SBAR();
    if (j + 3 < NT) SLOAD(SE, (j + 3) * KVBLK); SBAR();
    pv_d0(o, vb0 + (int)SHM_V, pa0, pa1, pa2, pa3); partialSM(pA0, pA1, m_reg, mnA, alA);
    __syncthreads(); SWAIT(); SWRITE(1, SO);
    RESC(alA); __syncthreads();
  }
  SBAR(); qkt(pB0, pB1, K_lds + SHM_K, qr, r32, hi, hfB);
  finishSM(pA0, pA1, alA, l_reg, pa0, pa1, pa2, pa3); SBAR();
  pv_d0(o, vb0, pa0, pa1, pa2, pa3); partialSM(pB0, pB1, m_reg, mnB, alB);
  __syncthreads(); RESC(alB);
  finishSM(pB0, pB1, alB, l_reg, pa0, pa1, pa2, pa3); SBAR();
  pv_d0(o, vb0 + (int)SHM_V, pa0, pa1, pa2, pa3);
  if (hi == 0) li_l[r32] = l_reg; asm volatile("s_waitcnt lgkmcnt(0)" ::: "memory");
  float rli[16];
#pragma unroll
  for (int r = 0; r < 16; ++r) rli[r] = __builtin_amdgcn_rcpf(li_l[crow(r, hi)]);
  __syncthreads();
  float* X = (float*)lds + rg * 4096;
  if (hf == 1) {
#pragma unroll
    for (int r = 0; r < 16; ++r)
#pragma unroll
      for (int d0 = 0; d0 < 4; ++d0) X[crow(r, hi) * 128 + d0 * 32 + r32] = o[d0][r] * rli[r] * lam;
  }
  __syncthreads();
  if (hf == 0) {
    float g4[4];
#pragma unroll
    for (int d0 = 0; d0 < 4; ++d0) g4[d0] = gsub[d0 * 32 + r32] * onorm;
    unsigned char* Ow = MIX + (size_t)(qrow0 + rg * 32) * D + 512 + h * 128 + r32;
#pragma unroll
    for (int r = 0; r < 16; ++r) {
      float v[4]; float ss = 0.f;
#pragma unroll
      for (int d0 = 0; d0 < 4; ++d0) { v[d0] = o[d0][r] * rli[r] - X[crow(r, hi) * 128 + d0 * 32 + r32]; ss += v[d0] * v[d0]; }
      ss += __shfl_xor(ss, 1); ss += __shfl_xor(ss, 2); ss += __shfl_xor(ss, 4); ss += __shfl_xor(ss, 8); ss += __shfl_xor(ss, 16);
      const float inv = rsqrtf(ss * (1.0f / 128.0f) + EPS);
#pragma unroll
      for (int d0 = 0; d0 < 4; ++d0) Ow[(size_t)crow(r, hi) * D + d0 * 32] = mix8_1(v[d0] * inv * g4[d0]);
    }
  }
  __syncthreads();
#undef TROW
#undef SLOAD
#undef SWRITE
#undef SWAIT
#undef RESC
}
#undef KSWZ
#undef SBAR
}

__device__ __forceinline__ void phase_attn_fast(KP p, int l, char* lds) {
  const int tid = opaque_tid();
  const bf16_t* PB = (const bf16_t*)(p->ws + WS_PB); unsigned char* MIX = (unsigned char*)(p->ws + WS_MIX);
  const float lam = ((const float*)(p->ws + WS_MOD))[2 * 9 * 6144 + l];
  const float lam_init = 0.8f - 0.6f * expf(-0.3f * (float)l);
  const float* gsub = p->in[I_GSUB] + l * 128;
  const int NU = 512 + (l == 0 ? 64 : 0);
  for (int L = blockIdx.x; L < NU; L += gridDim.x) {
    if (L < 512) {
      const int xcd = L & 7, j = (L >> 3) & 31, rd = L >> 8, pair = rd * 16 + xcd * 2 + (j >> 4), qb = j & 15, b = pair >> 2, h = pair & 3;
      att::attn_unit(PB, MIX, b * SEQ + qb * 128, h, RL + b * CTXL, b * SEQ, (CTXL + SEQ) / 64, lam, 1.0f - lam_init, gsub, lds, tid);
    } else {
      const int cu = L - 512, b = cu >> 3, h = (cu >> 1) & 3, qb = cu & 1;
      att::attn_unit(PB, MIX, RL + b * CTXL + qb * 128, h, RL + b * CTXL, 0, CTXL / 64, lam, 1.0f - lam_init, gsub, lds, tid);
    }
  }
}
__device__ __forceinline__ void phase_outproj(KP p, int l, LAS float* sm) {
    const int tid = opaque_tid(), ty = tid >> 4, tx = tid & 15;
    LAS int* rowidx = (LAS int*)(sm + 16 * 132 + 2 * 16 * 128);
    const bf16_t* MIX = (const bf16_t*)(p->ws + WS_MIX);
    const float* W = p->in[I_WOUT] + (size_t)l * D * D;
    const float* MOD = (const float*)(p->ws + WS_MOD) + (size_t)l * 9 * 6144;
    const int nMt = (l == 0 ? RT : RL) / 128, nNt = D / 128;
    for (int u = blockIdx.x; u < nMt * nNt; u += gridDim.x) {
        const int mt = u / nNt, nt = u % nNt;
        if (tid < 128) rowidx[tid] = mt * 128 + tid;
        __syncthreads();
        float acc[4][8], acc2[4][8];
        sgemm_tile<true, false>(sm, MIX, D, rowidx, W, nullptr, D, nt * 128, D, acc, acc2, tid);
#pragma unroll
        for (int i = 0; i < 4; ++i) { const int r = mt * 128 + ty * 4 + i; const int bb = row_bb(r); const float* xs = xsrc_row(p, l, r); float* xw = xw_row(p, r);
#pragma unroll
            for (int j = 0; j < 8; ++j) { const int c = nt * 128 + tx * 8 + j; xw[c] = xs[c] + MOD[bb * 6144 + 2048 + c] * acc[i][j]; } }
    }
}

__device__ __forceinline__ void phase_norm2_router(KP p, int l, LAS float* sm) {
    const int tid = opaque_tid(), lane = tid & 63, wave = tid >> 6;
    const int gw = blockIdx.x * NWAVES + wave, NGW = gridDim.x * NWAVES;
    const float* MOD = (const float*)(p->ws + WS_MOD) + (size_t)l * 9 * 6144;
    bf16_t* HB = (bf16_t*)(p->ws + WS_HB);
    unsigned* counts = (unsigned*)(p->ws + WS_CTL) + CW_CNT + l * 64;
    uint2* LIST = (uint2*)(p->ws + WS_LIST);
    const float* WR = p->in[I_WROUTER] + (size_t)l * D * NE;
    const float brt = p->in[I_BROUTER][l * NE + lane];
    LAS float* hs = sm + wave * 1024;
    const int nrows = (l == 0) ? RT : RL;
    for (int r = gw; r < nrows; r += NGW) {
        const int bb = row_bb(r); float hv[16];
        norm_row(xw_row(p, r), p->in[I_GN2] + l * D, MOD + bb * 6144 + 4096, MOD + bb * 6144 + 3072, HB + (size_t)r * D, lane, hv);
#pragma unroll
        for (int j = 0; j < 4; ++j) { *(LAS f32x4*)(hs + lane * 4 + 256 * j) = (f32x4){hv[4 * j], hv[4 * j + 1], hv[4 * j + 2], hv[4 * j + 3]}; }
        asm volatile("s_waitcnt lgkmcnt(0)" ::: "memory");
        float lg0 = 0.f, lg1 = 0.f, lg2 = 0.f, lg3 = 0.f;
        for (int k = 0; k < D; k += 4) {
            lg0 = fmaf(hs[k + 0], WR[(size_t)(k + 0) * NE + lane], lg0); lg1 = fmaf(hs[k + 1], WR[(size_t)(k + 1) * NE + lane], lg1);
            lg2 = fmaf(hs[k + 2], WR[(size_t)(k + 2) * NE + lane], lg2); lg3 = fmaf(hs[k + 3], WR[(size_t)(k + 3) * NE + lane], lg3);
        }
        const float logit = (lg0 + lg1) + (lg2 + lg3);
        const float score = 1.0f / (1.0f + expf(-logit));
        float key = score + brt;
        float ssum = 0.f; int myrank = -1;
#pragma unroll 1
        for (int k = 0; k < TOPK; ++k) {
            const float mx = wave_max(key);
            const unsigned long long bal = __ballot(key == mx);
            const int win = __ffsll((long long)bal) - 1;
            ssum += __shfl(score, win);
            if (lane == win) { myrank = k; key = -1e30f; }
        }
        if (myrank >= 0) {
            const float gate = score / ssum * 2.5f;
            const unsigned pos = atomicAdd(&counts[lane], 1u);
            uint2 e; e.x = (unsigned)(r * 8 + myrank); e.y = __float_as_uint(gate);
            LIST[(size_t)lane * RT + pos] = e;
        }
    }
}


namespace pg8 {
typedef short bf16x8 __attribute__((ext_vector_type(8)));
typedef unsigned u32x4 __attribute__((ext_vector_type(4)));
typedef float f32x2 __attribute__((ext_vector_type(2)));
typedef int i32x8 __attribute__((ext_vector_type(8)));
constexpr int FP8_WSCALE = 123;
constexpr int BM = 256, BK = 64, HALF = 128, HTB = HALF * BK * 2, STAGE_BYTES = 8 * HTB, NXCD = 8, WGM = 8, AUX_OFF = 132096;
__device__ __forceinline__ int lds_byte(int r, int c) { const int st = (r >> 4) * 2 + (c >> 5), rr = r & 15, cc = c & 31, ob = rr * 64 + cc * 2; return st * 1024 + (ob ^ (((ob >> 9) & 1) << 5)); }
__device__ __forceinline__ void stage_rc(int b, int& R, int& C) { const int st = b / 1024, sb = b % 1024, swz = sb ^ (((sb >> 9) & 1) << 5); R = (st >> 1) * 16 + swz / 64; C = (st & 1) * 32 + (swz % 64) / 2; }
__device__ __forceinline__ int perm32(int rho) { const int n = rho >> 4, i = rho & 15; return 8 * (i >> 2) + 4 * n + (i & 3); }
struct GUnit { const char* Bp; int e, m0, pn, cnt, sb; };
__device__ __forceinline__ unsigned cvt_pk_bf16(float lo, float hi) { unsigned r; asm volatile("v_cvt_pk_bf16_f32 %0, %1, %2" : "=v"(r) : "v"(lo), "v"(hi)); return r; }
__device__ __forceinline__ f32x2 gelu_pk(f32x2 v) {
    const f32x2 av = __builtin_elementwise_abs(v), d = av * 0.2316418882f + 1.0f;
    f32x2 t; t.x = __builtin_amdgcn_rcpf(d.x); t.y = __builtin_amdgcn_rcpf(d.y);
    f32x2 q = t * 0.5307027145f + (-0.7265760135f); q = q * t + 0.7107068705f; q = q * t + (-0.142248368f); q = q * t + 0.127414796f; q = q * t;
    const f32x2 s = (v * v) * (-0.72134752044f);
    f32x2 e; e.x = __builtin_amdgcn_exp2f(s.x); e.y = __builtin_amdgcn_exp2f(s.y);
    const f32x2 m = v * (q * e), r = v - m;
    f32x2 o; o.x = v.x < 0.f ? m.x : r.x; o.y = v.y < 0.f ? m.y : r.y; return o;
}
__device__ __forceinline__ int xcd_remap(int L, int n) { const int q = n / NXCD, r = n % NXCD, xcd = L % NXCD, off = L / NXCD; return (xcd < r ? xcd * (q + 1) : r * (q + 1) + (xcd - r) * q) + off; }

template <bool ALIGN_EPI, bool SP2, bool AUX, bool FP8, int ASCALE, class Sched, class Epi>
__device__ __forceinline__ void gemm_phase(LAS unsigned char* lds, const char* Abase, const int K, const Sched& S, const Epi& E, const int tid) {
    const int wid = __builtin_amdgcn_readfirstlane(tid >> 6), lane = tid & 63, wr = wid >> 2, wc = wid & 3, fr = lane & 15, fq = lane >> 4;
    const int nt = K / BK;
    int Rs[2], Cs[2]; unsigned voffB[2];
#pragma unroll
    for (int i = 0; i < 2; ++i) { int R, C; stage_rc(tid * 16 + i * 8192, R, C); Rs[i] = R; Cs[i] = C; const int Rb = 64 * (R >> 5) + perm32(R & 31); voffB[i] = (unsigned)(Rb * K + C) * 2u; }
    const size_t kstep = (size_t)(BK * 2);
    const size_t hstep = (size_t)32 * K * 2;
    const unsigned ldsw = (unsigned)wid * 1024u;
    const int aoff = lds_byte(wr * 64 + fr, fq * 8), boff = lds_byte(wc * 32 + fr, fq * 8);
    const int aoff8 = lds_byte(wr * 64 + fr, 32 * (fq >> 1) + 16 * (fq & 1)), boff8 = lds_byte(wc * 32 + fr, 32 * (fq >> 1) + 16 * (fq & 1));
#define PG8_SA(b, h) (((b) * 2 + (h)) * HTB)
#define PG8_SB(b, h) ((4 + (b) * 2 + (h)) * HTB)
#define PG8_STAGE_B(bufoff, gbase) do { _Pragma("unroll") for (int _i = 0; _i < 2; ++_i) \
        __builtin_amdgcn_global_load_lds((const unsigned*)((const char*)(gbase) + voffB[_i]), (LAS unsigned*)(lds + (bufoff) + ldsw + _i * 8192), 16, 0, 0); } while (0)
#define PG8_STAGE_A(bufoff, OFFS, h, koff) do { _Pragma("unroll") for (int _i = 0; _i < 2; ++_i) \
        __builtin_amdgcn_global_load_lds((const unsigned*)(Abase + (size_t)(OFFS)[h][_i] + (koff)), (LAS unsigned*)(lds + (bufoff) + ldsw + _i * 8192), 16, 0, 0); } while (0)
#define PG8_LDA(dst, b, h) do { if constexpr (FP8) { _Pragma("unroll") for (int m = 0; m < 4; ++m) { const u32x4 lo_ = *(const LAS u32x4*)(lds + PG8_SA(b, h) + aoff8 + m * 2048), hi_ = *(const LAS u32x4*)(lds + PG8_SA(b, h) + aoff8 + m * 2048 + 16); \
            dst##8[m] = (i32x8){(int)lo_.x, (int)lo_.y, (int)lo_.z, (int)lo_.w, (int)hi_.x, (int)hi_.y, (int)hi_.z, (int)hi_.w}; } } \
        else { _Pragma("unroll") for (int m = 0; m < 4; ++m) _Pragma("unroll") for (int k = 0; k < 2; ++k) dst[m][k] = *(const LAS bf16x8*)(lds + PG8_SA(b, h) + aoff + m * 2048 + k * 1024); } } while (0)
#define PG8_LDB(dst, b, h) do { if constexpr (FP8) { _Pragma("unroll") for (int n = 0; n < 2; ++n) { const u32x4 lo_ = *(const LAS u32x4*)(lds + PG8_SB(b, h) + boff8 + n * 2048), hi_ = *(const LAS u32x4*)(lds + PG8_SB(b, h) + boff8 + n * 2048 + 16); \
            dst##8[n] = (i32x8){(int)lo_.x, (int)lo_.y, (int)lo_.z, (int)lo_.w, (int)hi_.x, (int)hi_.y, (int)hi_.z, (int)hi_.w}; } } \
        else { _Pragma("unroll") for (int n = 0; n < 2; ++n) _Pragma("unroll") for (int k = 0; k < 2; ++k) dst[n][k] = *(const LAS bf16x8*)(lds + PG8_SB(b, h) + boff + n * 2048 + k * 1024); } } while (0)
#define PG8_MMA(ai, bj, At, Bt) do { __builtin_amdgcn_s_setprio(1); if constexpr (FP8) { _Pragma("unroll") for (int m = 0; m < 4; ++m) _Pragma("unroll") for (int n = 0; n < 2; ++n) \
            acc[ai][bj][m][n] = __builtin_amdgcn_mfma_scale_f32_16x16x128_f8f6f4(Bt##8[n], At##8[m], acc[ai][bj][m][n], 0, 0, 0, FP8_WSCALE, 0, ASCALE); } \
        else { _Pragma("unroll") for (int m = 0; m < 4; ++m) _Pragma("unroll") for (int n = 0; n < 2; ++n) _Pragma("unroll") for (int k = 0; k < 2; ++k) \
        acc[ai][bj][m][n] = __builtin_amdgcn_mfma_f32_16x16x32_bf16(Bt[n][k], At[m][k], acc[ai][bj][m][n], 0, 0, 0); } __builtin_amdgcn_s_setprio(0); } while (0)
#define PG8_WAIT_V(n) asm volatile("s_waitcnt vmcnt(" #n ")" ::: "memory")
#define PG8_WAIT_L(n) asm volatile("s_waitcnt lgkmcnt(" #n ")" ::: "memory")
#define PG8_BAR __builtin_amdgcn_s_barrier()
#define PG8_SCHED __builtin_amdgcn_sched_barrier(0)
    LAS unsigned* auxtab = (LAS unsigned*)(lds + AUX_OFF);
    LAS unsigned* ptab = (LAS unsigned*)(lds + AUX_OFF + 2048);
#define PG8_PTAB(u, sel) do { if constexpr (AUX) { if (wid < 4) __builtin_amdgcn_global_load_lds((const unsigned*)S.pair_src(u, wid * 64 + lane), ptab + (sel) * 256 + wid * 64, 4, 0, 0); } } while (0)
#define PG8_AUX(u, sel) do { if constexpr (AUX) { if (wid < 4) __builtin_amdgcn_global_load_lds((const unsigned*)S.aux_src(u, wid * 64 + lane), auxtab + (sel) * 256 + wid * 64, 4, 0, 0); } } while (0)
    GUnit cur, nxt; int ui = 0;
    if (!S.next(0, cur)) return;
    f32x4 acc[2][2][4][2];
#pragma unroll
    for (int a = 0; a < 2; ++a)
#pragma unroll
        for (int b = 0; b < 2; ++b)
#pragma unroll
            for (int m = 0; m < 4; ++m)
#pragma unroll
                for (int n = 0; n < 2; ++n) acc[a][b][m][n] = (f32x4){0.f, 0.f, 0.f, 0.f};
    bf16x8 At[4][2], B0[2][2], B1[2][2];
    i32x8 At8[4], B08[2], B18[2];
    unsigned cO[2][2];
    if constexpr (AUX) {
        PG8_PTAB(cur, 0); { GUnit n1; if (S.next(1, n1)) PG8_PTAB(n1, 1); }
        asm volatile("s_waitcnt vmcnt(0)" ::: "memory"); __builtin_amdgcn_s_barrier();
        S.a_offs_lds(cur, Rs, Cs, cO, ptab);
    } else S.a_offs(cur, Rs, Cs, cO);
    PG8_AUX(cur, 0);
    const char* cB = cur.Bp;
    if constexpr (SP2) {
        PG8_STAGE_B(PG8_SB(0, 0), cB); PG8_STAGE_B(PG8_SB(0, 1), cB + hstep); PG8_STAGE_A(PG8_SA(0, 0), cO, 0, 0); PG8_STAGE_A(PG8_SA(0, 1), cO, 1, 0);
        if (wr == 1) PG8_BAR;
        PG8_WAIT_V(2); PG8_BAR;
        PG8_STAGE_B(PG8_SB(1, 0), cB + kstep); PG8_STAGE_A(PG8_SA(1, 0), cO, 0, kstep); PG8_STAGE_B(PG8_SB(1, 1), cB + hstep + kstep);
        PG8_WAIT_V(6); PG8_BAR;
    } else {
    PG8_STAGE_B(PG8_SB(0, 0), cB); PG8_STAGE_A(PG8_SA(0, 0), cO, 0, 0); PG8_STAGE_B(PG8_SB(0, 1), cB + hstep); PG8_STAGE_A(PG8_SA(0, 1), cO, 1, 0);
    if (wr == 1) PG8_BAR;
    PG8_WAIT_V(4); PG8_BAR;
    PG8_STAGE_B(PG8_SB(1, 0), cB + kstep); PG8_STAGE_A(PG8_SA(1, 0), cO, 0, kstep); PG8_STAGE_B(PG8_SB(1, 1), cB + hstep + kstep);
    PG8_WAIT_V(6); PG8_BAR;
    }
    for (;;) {
        const bool has_next = S.next(ui + 1, nxt);
        const char* nB = has_next ? nxt.Bp : cB;
#pragma unroll 1
        for (int t = 0; t < nt; t += 2) {
            const bool last = (t == nt - 2);
            const size_t k1 = (size_t)(t + 1) * kstep, k2 = last ? (size_t)0 : (size_t)(t + 2) * kstep, k3 = k2 + kstep;
            const char* b2 = last ? nB : cB + (size_t)(t + 2) * kstep; const char* b3 = b2 + kstep;
            if constexpr (SP2) {
            PG8_LDB(B0, 0, 0); PG8_LDB(B1, 0, 1); PG8_SCHED; PG8_LDA(At, 0, 0); PG8_STAGE_A(PG8_SA(1, 1), cO, 1, k1);
            PG8_WAIT_V(8); PG8_WAIT_L(0); PG8_BAR; PG8_MMA(0, 0, At, B0); PG8_MMA(0, 1, At, B1); PG8_BAR; PG8_SCHED;
            if (last && has_next) { if constexpr (AUX) { S.a_offs_lds(nxt, Rs, Cs, cO, ptab + ((ui + 1) & 1) * 256); GUnit n2; if (S.next(ui + 2, n2)) PG8_PTAB(n2, ui & 1); } else S.a_offs(nxt, Rs, Cs, cO); PG8_AUX(nxt, (ui + 1) & 1); }
            PG8_LDA(At, 0, 1); PG8_STAGE_B(PG8_SB(0, 0), b2); PG8_STAGE_B(PG8_SB(0, 1), b2 + hstep); PG8_STAGE_A(PG8_SA(0, 0), cO, 0, k2);
            PG8_WAIT_V(8); PG8_WAIT_L(0); PG8_BAR; PG8_MMA(1, 0, At, B0); PG8_MMA(1, 1, At, B1); PG8_BAR; PG8_SCHED;
            PG8_LDB(B0, 1, 0); PG8_LDB(B1, 1, 1); PG8_SCHED; PG8_LDA(At, 1, 0); PG8_STAGE_A(PG8_SA(0, 1), cO, 1, k2);
            PG8_WAIT_V(8); PG8_WAIT_L(0); PG8_BAR; PG8_MMA(0, 0, At, B0); PG8_MMA(0, 1, At, B1); PG8_BAR; PG8_SCHED;
            PG8_LDA(At, 1, 1); PG8_STAGE_B(PG8_SB(1, 0), b3); PG8_STAGE_B(PG8_SB(1, 1), b3 + hstep); PG8_STAGE_A(PG8_SA(1, 0), cO, 0, k3);
            PG8_WAIT_V(8); PG8_WAIT_L(0); PG8_BAR; PG8_MMA(1, 0, At, B0); PG8_MMA(1, 1, At, B1); PG8_BAR; PG8_SCHED;
            } else {
            PG8_LDB(B0, 0, 0); PG8_SCHED; PG8_LDA(At, 0, 0); PG8_STAGE_A(PG8_SA(1, 1), cO, 1, k1);
            PG8_WAIT_L(8); PG8_BAR; PG8_WAIT_L(0); PG8_MMA(0, 0, At, B0); PG8_BAR; PG8_SCHED;
            if (last && has_next) { if constexpr (AUX) { S.a_offs_lds(nxt, Rs, Cs, cO, ptab + ((ui + 1) & 1) * 256); GUnit n2; if (S.next(ui + 2, n2)) PG8_PTAB(n2, ui & 1); } else S.a_offs(nxt, Rs, Cs, cO); PG8_AUX(nxt, (ui + 1) & 1); }
            PG8_LDB(B1, 0, 1); PG8_STAGE_B(PG8_SB(0, 0), b2);
            PG8_BAR; PG8_WAIT_L(0); PG8_MMA(0, 1, At, B1); PG8_BAR;
            PG8_LDA(At, 0, 1); PG8_STAGE_A(PG8_SA(0, 0), cO, 0, k2);
            PG8_BAR; PG8_WAIT_L(0); PG8_MMA(1, 0, At, B0); PG8_BAR; PG8_SCHED;
            PG8_STAGE_B(PG8_SB(0, 1), b2 + hstep);
            PG8_WAIT_V(6); PG8_BAR; PG8_MMA(1, 1, At, B1); PG8_BAR;
            PG8_LDB(B0, 1, 0); PG8_SCHED; PG8_LDA(At, 1, 0); PG8_STAGE_A(PG8_SA(0, 1), cO, 1, k2);
            PG8_WAIT_L(8); PG8_BAR; PG8_WAIT_L(0); PG8_MMA(0, 0, At, B0); PG8_BAR; PG8_SCHED;
            PG8_LDB(B1, 1, 1); PG8_STAGE_B(PG8_SB(1, 0), b3);
            PG8_BAR; PG8_WAIT_L(0); PG8_MMA(0, 1, At, B1); PG8_BAR;
            PG8_LDA(At, 1, 1); PG8_STAGE_A(PG8_SA(1, 0), cO, 0, k3);
            PG8_BAR; PG8_WAIT_L(0); PG8_MMA(1, 0, At, B0); PG8_BAR; PG8_SCHED;
            PG8_STAGE_B(PG8_SB(1, 1), b3 + hstep);
            PG8_WAIT_V(6); PG8_BAR; PG8_MMA(1, 1, At, B1); PG8_BAR;
            }
        }
        if constexpr (ALIGN_EPI) { if (wr == 0) PG8_BAR; }
        E(acc, cur, wr, wc, fr, fq, auxtab + (ui & 1) * 256);
        if (!has_next) break;
#pragma unroll
        for (int a = 0; a < 2; ++a)
#pragma unroll
            for (int b = 0; b < 2; ++b)
#pragma unroll
                for (int m = 0; m < 4; ++m)
#pragma unroll
                    for (int n = 0; n < 2; ++n) acc[a][b][m][n] = (f32x4){0.f, 0.f, 0.f, 0.f};
        cur = nxt; cB = nB; ++ui;
        if constexpr (ALIGN_EPI) { if (wr == 1) PG8_BAR; }
    }
    PG8_WAIT_V(0);
    if constexpr (!ALIGN_EPI) { if (wr == 0) PG8_BAR; }
    PG8_BAR;
#undef PG8_SA
#undef PG8_SB
#undef PG8_STAGE_A
#undef PG8_STAGE_B
#undef PG8_LDA
#undef PG8_LDB
#undef PG8_MMA
#undef PG8_WAIT_V
#undef PG8_WAIT_L
#undef PG8_BAR
#undef PG8_SCHED
#undef PG8_AUX
#undef PG8_PTAB
}

struct SchedDense {
    int nM, nN, nwg, G, c, K, nExtra, xpm0, xpn0, xn; const char* Bt;
    __device__ __forceinline__ bool next(int i, GUnit& u) const {
        const int L = i * G + c; if (L >= nwg + nExtra) return false;
        int pm, pn;
        if (L < nwg) { const int wgid = xcd_remap(L, nwg); const int nig = WGM * nN, gid = wgid / nig, fm = gid * WGM, gsz = (nM - fm) < WGM ? (nM - fm) : WGM; pm = fm + ((wgid % nig) % gsz); pn = (wgid % nig) / gsz; }
        else { const int j = L - nwg; pm = xpm0 + j / xn; pn = xpn0 + j % xn; }
        u.Bp = Bt + (size_t)pn * 256 * K * 2; u.e = -1; u.m0 = pm * 256; u.pn = pn; u.cnt = 0x7fffffff; u.sb = 0; return true;
    }
    __device__ __forceinline__ void a_offs(const GUnit& u, const int (&Rs)[2], const int (&Cs)[2], unsigned (&o)[2][2]) const {
#pragma unroll
        for (int h = 0; h < 2; ++h)
#pragma unroll
            for (int i = 0; i < 2; ++i) o[h][i] = (unsigned)((u.m0 + Rs[i] + 128 * h) * K + Cs[i]) * 2u;
    }
    __device__ __forceinline__ const void* aux_src(const GUnit&, int) const { return nullptr; }
    __device__ __forceinline__ const void* pair_src(const GUnit&, int) const { return nullptr; }
    __device__ __forceinline__ void a_offs_lds(const GUnit& u, const int (&Rs)[2], const int (&Cs)[2], unsigned (&o)[2][2], const LAS unsigned*) const { a_offs(u, Rs, Cs, o); }
};
template <bool UP> struct SchedMoe {
    const LAS int* tstart; const LAS int* sbase; const LAS int* cntv; int NPN, G, c, nU, K; const char* Wbase; const uint2* LIST;
    __device__ __forceinline__ bool next(int i, GUnit& u) const {
        const int L = i * G + c; if (L >= nU) return false;
        const int uu = xcd_remap(L, nU), t = uu / NPN, pn = uu % NPN;
        const int lane = __builtin_amdgcn_mbcnt_hi(~0u, __builtin_amdgcn_mbcnt_lo(~0u, 0u));
        const int e = __builtin_popcountll(__ballot(tstart[lane + 1] <= t));
        u.e = e; u.m0 = (t - tstart[e]) * 256; u.pn = pn; u.cnt = cntv[e]; u.sb = sbase[e];
        u.Bp = Wbase + (size_t)e * WEXP_STRIDE + (size_t)pn * 256 * K * 2; return true;
    }
    __device__ __forceinline__ void a_offs(const GUnit& u, const int (&Rs)[2], const int (&Cs)[2], unsigned (&o)[2][2]) const {
#pragma unroll
        for (int h = 0; h < 2; ++h)
#pragma unroll
            for (int i = 0; i < 2; ++i) {
                const int slot = u.m0 + Rs[i] + 128 * h; int row;
                if (UP) { row = 0; if (slot < u.cnt) row = u.e < 64 ? (int)(LIST[(size_t)u.e * RT + slot].x >> 3) : slot; }
                else row = u.sb + slot;
                o[h][i] = (unsigned)(row * K + Cs[i]) * 2u;
            }
    }
    __device__ __forceinline__ const void* pair_src(const GUnit& u, int s) const { return (const unsigned*)(LIST + (size_t)(u.e < 64 ? u.e : 0) * RT + u.m0 + s); }
    __device__ __forceinline__ void a_offs_lds(const GUnit& u, const int (&Rs)[2], const int (&Cs)[2], unsigned (&o)[2][2], const LAS unsigned* pt) const {
#pragma unroll
        for (int h = 0; h < 2; ++h)
#pragma unroll
            for (int i = 0; i < 2; ++i) {
                const int sl = Rs[i] + 128 * h, slot = u.m0 + sl; const int pr = (int)(pt[sl] >> 3);
                int row = 0; if (slot < u.cnt) row = u.e < 64 ? pr : slot;
                o[h][i] = (unsigned)(row * K + Cs[i]) * 2u;
            }
    }
    __device__ __forceinline__ const void* aux_src(const GUnit& u, int s) const { return (const unsigned*)(LIST + (size_t)(u.e < 64 ? u.e : 0) * RT + u.m0 + s) + (UP ? 1 : 0); }
};
}

struct EpiInproj { bf16_t* PB;
    __device__ __forceinline__ void operator()(const f32x4 (&acc)[2][2][4][2], const pg8::GUnit& u, int wr, int wc, int fr, int fq, const LAS unsigned* aux) const {
        const int row0 = u.m0 + wr * 64 + fr, col0 = u.pn * 256 + wc * 64 + 8 * fq; const bool act = u.pn < 2;
#pragma unroll
        for (int ai = 0; ai < 2; ++ai)
#pragma unroll
            for (int m = 0; m < 4; ++m) { bf16_t* rowp = PB + (size_t)(row0 + ai * 128 + m * 16) * DIN + col0;
#pragma unroll
                for (int bj = 0; bj < 2; ++bj) { f32x4 v0 = acc[ai][bj][m][0], v1 = acc[ai][bj][m][1];
                    if (act) { const pg8::f32x2 a = pg8::gelu_pk((pg8::f32x2){v0[0], v0[1]}), b = pg8::gelu_pk((pg8::f32x2){v0[2], v0[3]}), c = pg8::gelu_pk((pg8::f32x2){v1[0], v1[1]}), d = pg8::gelu_pk((pg8::f32x2){v1[2], v1[3]});
                        v0 = (f32x4){a.x, a.y, b.x, b.y}; v1 = (f32x4){c.x, c.y, d.x, d.y}; }
                    pg8::u32x4 w; w.x = pg8::cvt_pk_bf16(v0[0], v0[1]); w.y = pg8::cvt_pk_bf16(v0[2], v0[3]); w.z = pg8::cvt_pk_bf16(v1[0], v1[1]); w.w = pg8::cvt_pk_bf16(v1[2], v1[3]);
                    *(pg8::u32x4*)(rowp + bj * 32) = w; } }
    }
};
struct EpiOutproj { bf16_t* Y;
    __device__ __forceinline__ void operator()(const f32x4 (&acc)[2][2][4][2], const pg8::GUnit& u, int wr, int wc, int fr, int fq, const LAS unsigned* aux) const {
        const int row0 = u.m0 + wr * 64 + fr, col0 = u.pn * 256 + wc * 64 + 8 * fq;
#pragma unroll
        for (int ai = 0; ai < 2; ++ai)
#pragma unroll
            for (int m = 0; m < 4; ++m) { bf16_t* rowp = Y + (size_t)(row0 + ai * 128 + m * 16) * D + col0;
#pragma unroll
                for (int bj = 0; bj < 2; ++bj) { const f32x4 v0 = acc[ai][bj][m][0], v1 = acc[ai][bj][m][1];
                    pg8::u32x4 w; w.x = pg8::cvt_pk_bf16(v0[0], v0[1]); w.y = pg8::cvt_pk_bf16(v0[2], v0[3]); w.z = pg8::cvt_pk_bf16(v1[0], v1[1]); w.w = pg8::cvt_pk_bf16(v1[2], v1[3]);
                    *(pg8::u32x4*)(rowp + bj * 32) = w; } }
    }
};
struct EpiMoeUp { const uint2* LIST; bf16_t* HID;
    __device__ __forceinline__ void operator()(const f32x4 (&acc)[2][2][4][2], const pg8::GUnit& u, int wr, int wc, int fr, int fq, const LAS unsigned* aux) const {
        float gt[2][4];
#pragma unroll
        for (int ai = 0; ai < 2; ++ai)
#pragma unroll
            for (int m = 0; m < 4; ++m) gt[ai][m] = __uint_as_float(aux[ai * 128 + wr * 64 + m * 16 + fr]);
#pragma unroll
        for (int ai = 0; ai < 2; ++ai)
#pragma unroll
            for (int m = 0; m < 4; ++m) { const int slot = u.m0 + ai * 128 + wr * 64 + m * 16 + fr;
                const float gtv = u.e < 64 ? gt[ai][m] : 1.0f;
                float h[8];
#pragma unroll
                for (int n = 0; n < 2; ++n)
#pragma unroll
                    for (int j = 0; j < 4; ++j) { const float gv = acc[ai][0][m][n][j], uv = acc[ai][1][m][n][j]; h[n * 4 + j] = gv * __builtin_amdgcn_rcpf(1.0f + __expf(-gv)) * uv * gtv; }
                int w0 = 0, w1 = 0;
                w0 = __builtin_amdgcn_cvt_pk_fp8_f32(sat8<16>(h[0]), sat8<16>(h[1]), w0, false); w0 = __builtin_amdgcn_cvt_pk_fp8_f32(sat8<16>(h[2]), sat8<16>(h[3]), w0, true);
                w1 = __builtin_amdgcn_cvt_pk_fp8_f32(sat8<16>(h[4]), sat8<16>(h[5]), w1, false); w1 = __builtin_amdgcn_cvt_pk_fp8_f32(sat8<16>(h[6]), sat8<16>(h[7]), w1, true);
                uint2 w; w.x = (unsigned)w0; w.y = (unsigned)w1;
                if (slot < u.cnt) *(uint2*)((unsigned char*)HID + (size_t)(u.sb + slot) * DE + u.pn * 128 + wc * 32 + 8 * fq) = w; }
    }
};
struct EpiMoeDown { const uint2* LIST; bf16_t* ROWS; KP p; const float* g2;
    __device__ __forceinline__ void operator()(const f32x4 (&acc)[2][2][4][2], const pg8::GUnit& u, int wr, int wc, int fr, int fq, const LAS unsigned* aux) const {
        const int col0 = u.pn * 256 + wc * 64 + 8 * fq;
        if (u.e < 64) {
            unsigned pr[2][4];
#pragma unroll
            for (int ai = 0; ai < 2; ++ai)
#pragma unroll
                for (int m = 0; m < 4; ++m) pr[ai][m] = aux[ai * 128 + wr * 64 + m * 16 + fr];
#pragma unroll
            for (int ai = 0; ai < 2; ++ai)
#pragma unroll
                for (int m = 0; m < 4; ++m) { const int slot = u.m0 + ai * 128 + wr * 64 + m * 16 + fr;
                    if (slot < u.cnt) { unsigned char* dst = (unsigned char*)ROWS + (size_t)pr[ai][m] * D + col0;
#pragma unroll
                        for (int bj = 0; bj < 2; ++bj) { const f32x4 v0 = acc[ai][bj][m][0] * ROWS_SCALE, v1 = acc[ai][bj][m][1] * ROWS_SCALE;
                            int w0 = 0, w1 = 0;
                            w0 = __builtin_amdgcn_cvt_pk_fp8_f32(v0[0], v0[1], w0, false); w0 = __builtin_amdgcn_cvt_pk_fp8_f32(v0[2], v0[3], w0, true);
                            w1 = __builtin_amdgcn_cvt_pk_fp8_f32(v1[0], v1[1], w1, false); w1 = __builtin_amdgcn_cvt_pk_fp8_f32(v1[2], v1[3], w1, true);
                            uint2 w; w.x = (unsigned)w0; w.y = (unsigned)w1;
                            *(uint2*)(dst + bj * 32) = w; } } }
        } else {
            const int bb = u.m0 < RL ? u.m0 / SEQ : 8;
            f32x4 g[2][2];
#pragma unroll
            for (int bj = 0; bj < 2; ++bj)
#pragma unroll
                for (int n = 0; n < 2; ++n) g[bj][n] = *(const f32x4*)(g2 + bb * 6144 + col0 + bj * 32 + 4 * n);
#pragma unroll
            for (int ai = 0; ai < 2; ++ai) {
                f32x4 x[4][2][2];
#pragma unroll
                for (int m = 0; m < 4; ++m) { const float* xw = xw_row(p, u.m0 + ai * 128 + wr * 64 + m * 16 + fr) + col0;
#pragma unroll
                    for (int bj = 0; bj < 2; ++bj)
#pragma unroll
                        for (int n = 0; n < 2; ++n) x[m][bj][n] = *(const f32x4*)(xw + bj * 32 + 4 * n); }
#pragma unroll
                for (int m = 0; m < 4; ++m) { float* xw = xw_row(p, u.m0 + ai * 128 + wr * 64 + m * 16 + fr) + col0;
#pragma unroll
                    for (int bj = 0; bj < 2; ++bj)
#pragma unroll
                        for (int n = 0; n < 2; ++n) *(f32x4*)(xw + bj * 32 + 4 * n) = x[m][bj][n] + g[bj][n] * acc[ai][bj][m][n]; }
                asm volatile("" ::: "memory");
            }
        }
    }
};

struct CvtJob { const float* src; int nsrc, k0, n0; bf16_t* dst; int dpitch, rowbase, rstride, blksh, f8; };
__device__ __forceinline__ CvtJob cvt_job_dense(KP p, int idx) {
    CvtJob j; const int l = idx / 120, r = idx % 120;
    if (r < 88) { const int kt = r / 11, nt = r % 11; j.src = p->in[I_WIN] + (size_t)l * D * DIN; j.nsrc = DIN; j.k0 = kt * 128; j.n0 = nt * 256; j.dst = (bf16_t*)(p->ws + WS_WIN + (size_t)l * DIN * D); j.dpitch = D; j.rowbase = nt * 256; j.rstride = 128; j.blksh = 7; j.f8 = 1; }
    else { const int q = r - 88, kt = q / 4, nt = q % 4; j.src = p->in[I_WOUT] + (size_t)l * D * D; j.nsrc = D; j.k0 = kt * 128; j.n0 = nt * 256; j.dst = (bf16_t*)(p->ws + WS_WOUT + (size_t)l * D * D); j.dpitch = D; j.rowbase = nt * 256; j.rstride = 128; j.blksh = 7; j.f8 = 1; }
    return j;
}
__device__ __forceinline__ CvtJob cvt_job_expert(KP p, int l, int idx) {
    CvtJob j; const int e = idx / 24, r = idx % 24, part = r >> 3, tile = r & 7;
    unsigned char* wb = p->ws + WS_WEXP + (size_t)l * WEXP_LAYER + (size_t)e * WEXP_STRIDE;
    if (part < 2) {
        const float* s = part == 0 ? (e < 64 ? p->in[I_WGATE] + ((size_t)l * NE + e) * D * DE : p->in[I_SGATE] + (size_t)l * D * DE)
                                   : (e < 64 ? p->in[I_WUP] + ((size_t)l * NE + e) * D * DE : p->in[I_SUP] + (size_t)l * D * DE);
        j.src = s; j.nsrc = DE; j.k0 = tile * 128; j.n0 = 0; j.dst = (bf16_t*)wb; j.dpitch = D; j.rowbase = part * 32; j.rstride = 64; j.blksh = 5; j.f8 = 1;
    } else {
        const float* s = e < 64 ? p->in[I_WDOWN] + ((size_t)l * NE + e) * DE * D : p->in[I_SDOWN] + (size_t)l * DE * D;
        const int kt = tile >> 2, nt = tile & 3;
        j.src = s; j.nsrc = D; j.k0 = kt * 128; j.n0 = nt * 256; j.dst = (bf16_t*)(wb + WEXP_DOWN); j.dpitch = DE; j.rowbase = nt * 256; j.rstride = 128; j.blksh = 7; j.f8 = 1;
    }
    return j;
}
constexpr int CVT_PITCH = 272;
__device__ __forceinline__ void cvt_load(const CvtJob& j, int w, int lane, f32x4 (&r)[16]) {
    const float* s = j.src + (size_t)(j.k0 + w * 16) * j.nsrc + j.n0 + lane * 4;
#pragma unroll
    for (int q = 0; q < 16; ++q) r[q] = __builtin_nontemporal_load((const f32x4*)(s + (size_t)q * j.nsrc));
}
__device__ __forceinline__ void cvt_to_lds(LAS unsigned char* lds, int w, int lane, const f32x4 (&r)[16], int f8) {
    if (f8) {
#pragma unroll
        for (int jn = 0; jn < 4; ++jn) { int q[4];
#pragma unroll
            for (int g = 0; g < 4; ++g) { int v = 0; v = __builtin_amdgcn_cvt_pk_fp8_f32(r[4 * g][jn] * 16.0f, r[4 * g + 1][jn] * 16.0f, v, false); v = __builtin_amdgcn_cvt_pk_fp8_f32(r[4 * g + 2][jn] * 16.0f, r[4 * g + 3][jn] * 16.0f, v, true); q[g] = v; }
            *(LAS pg8::u32x4*)(lds + (lane * 4 + jn) * 144 + w * 16) = (pg8::u32x4){(unsigned)q[0], (unsigned)q[1], (unsigned)q[2], (unsigned)q[3]}; }
        return;
    }
#pragma unroll
    for (int jn = 0; jn < 4; ++jn)
#pragma unroll
        for (int g = 0; g < 2; ++g) {
            pg8::u32x4 v; v.x = pg8::cvt_pk_bf16(r[g * 8 + 0][jn], r[g * 8 + 1][jn]); v.y = pg8::cvt_pk_bf16(r[g * 8 + 2][jn], r[g * 8 + 3][jn]);
            v.z = pg8::cvt_pk_bf16(r[g * 8 + 4][jn], r[g * 8 + 5][jn]); v.w = pg8::cvt_pk_bf16(r[g * 8 + 6][jn], r[g * 8 + 7][jn]);
            *(LAS pg8::u32x4*)(lds + (lane * 4 + jn) * CVT_PITCH + (w * 16 + g * 8) * 2) = v;
        }
}
__device__ __forceinline__ void cvt_write_out(const CvtJob& j, const LAS unsigned char* lds, int tid) {
    if (j.f8) {
#pragma unroll
        for (int rr = 0; rr < 4; ++rr) { const int n = (tid >> 3) + 64 * rr, kc = tid & 7;
            const pg8::u32x4 v = *(const LAS pg8::u32x4*)(lds + n * 144 + kc * 16);
            const int drow = j.rowbase + (n >> j.blksh) * j.rstride + (n & ((1 << j.blksh) - 1));
            *(pg8::u32x4*)((unsigned char*)j.dst + (size_t)drow * j.dpitch + j.k0 + kc * 16) = v; }
        return;
    }
#pragma unroll
    for (int rr = 0; rr < 8; ++rr) { const int n = (tid >> 4) + 32 * rr, kc = tid & 15;
        const pg8::u32x4 v = *(const LAS pg8::u32x4*)(lds + n * CVT_PITCH + kc * 16);
        const int drow = j.rowbase + (n >> j.blksh) * j.rstride + (n & ((1 << j.blksh) - 1));
        *(pg8::u32x4*)(j.dst + (size_t)drow * j.dpitch + j.k0 + kc * 8) = v; }
}
__device__ __forceinline__ void convert_weights(KP p, LAS unsigned char* lds, int nd, int ne, int l, const int tid) {
    const int w = tid >> 6, lane = tid & 63; const int ntot = nd + ne;
    int idx = blockIdx.x; if (idx >= ntot) return;
    CvtJob cur = idx < nd ? cvt_job_dense(p, idx) : cvt_job_expert(p, l, idx - nd);
    f32x4 r[16];
    cvt_load(cur, w, lane, r);
    for (;;) {
        __syncthreads();
        cvt_to_lds(lds, w, lane, r, cur.f8);
        __syncthreads();
        const int nidx = idx + gridDim.x; const bool more = nidx < ntot;
        CvtJob nx = cur;
        if (more) { nx = nidx < nd ? cvt_job_dense(p, nidx) : cvt_job_expert(p, l, nidx - nd); cvt_load(nx, w, lane, r); }
        cvt_write_out(cur, lds, tid);
        if (!more) break;
        cur = nx; idx = nidx;
    }
    __syncthreads();
}

struct GroupMap { LAS int* tstart; LAS int* sbase; LAS int* cnt; };
__device__ __forceinline__ GroupMap build_group_map(KP p, int l, LAS int* base, int TM, int nrows, const int tid) {
    GroupMap g; g.tstart = base; g.sbase = base + 72; g.cnt = base + 144;
    const unsigned* counts = (const unsigned*)(p->ws + WS_CTL) + CW_CNT + l * 64;
    if (tid < 64) {
        int c = (int)counts[tid]; if (c > nrows) c = nrows;
        const int tl = (c + TM - 1) / TM, pd = (c + 255) & ~255;
        int st = tl, sp = pd;
#pragma unroll
        for (int o = 1; o < 64; o <<= 1) { const int a = __shfl_up(st, o), b = __shfl_up(sp, o); if (tid >= o) { st += a; sp += b; } }
        g.tstart[tid] = st - tl; g.sbase[tid] = sp - pd; g.cnt[tid] = c;
        if (tid == 63) { g.tstart[64] = st; g.sbase[64] = HID_SHARED_BASE; g.cnt[64] = nrows; g.tstart[65] = st + (nrows + TM - 1) / TM; }
    }
    __syncthreads();
    return g;
}

__device__ __forceinline__ void phase_moe_up(KP p, int l, LAS float* sm) {
    const int tid = opaque_tid(), ty = tid >> 4, tx = tid & 15;
    LAS int* rowidx = (LAS int*)(sm + 16 * 132 + 2 * 16 * 128);
    LAS float* gates = (LAS float*)(rowidx + 128);
    LAS int* gm = (LAS int*)(gates + 128);
    const int nrows = (l == 0) ? RT : RL;
    const GroupMap G = build_group_map(p, l, gm, 128, nrows, tid);
    const bf16_t* HB = (const bf16_t*)(p->ws + WS_HB); bf16_t* HID = (bf16_t*)(p->ws + WS_HID);
    const uint2* LIST = (const uint2*)(p->ws + WS_LIST);
    const int ntiles = G.tstart[65];
    for (int u = blockIdx.x; u < ntiles * 2; u += gridDim.x) {
        const int t = u >> 1, nt = u & 1;
        int e = 0; while (G.tstart[e + 1] <= t) ++e;
        const int m0 = (t - G.tstart[e]) * 128, cnt = G.cnt[e];
        __syncthreads();
        if (tid < 128) {
            const int m = m0 + tid;
            if (m < cnt) { if (e < 64) { const uint2 en = LIST[(size_t)e * RT + m]; rowidx[tid] = (int)(en.x >> 3); gates[tid] = __uint_as_float(en.y); } else { rowidx[tid] = m; gates[tid] = 1.0f; } }
            else { rowidx[tid] = -1; gates[tid] = 0.f; }
        }
        __syncthreads();
        const float* Wg = e < 64 ? p->in[I_WGATE] + ((size_t)l * NE + e) * D * DE : p->in[I_SGATE] + (size_t)l * D * DE;
        const float* Wu = e < 64 ? p->in[I_WUP] + ((size_t)l * NE + e) * D * DE : p->in[I_SUP] + (size_t)l * D * DE;
        float acc[4][8], acc2[4][8];
        sgemm_tile<true, true>(sm, HB, D, rowidx, Wg, Wu, DE, nt * 128, D, acc, acc2, tid);
#pragma unroll
        for (int i = 0; i < 4; ++i) { const int mi = ty * 4 + i; const int m = m0 + mi;
            if (m < cnt) { const float gt = gates[mi]; bf16_t* hp = HID + (size_t)(G.sbase[e] + m) * DE + nt * 128 + tx * 8;
#pragma unroll
                for (int j = 0; j < 8; ++j) hp[j] = f2bf(silu_f(acc[i][j]) * acc2[i][j] * gt); } }
    }
}

__device__ __forceinline__ void phase_moe_down(KP p, int l, LAS float* sm) {
    const int tid = opaque_tid(), ty = tid >> 4, tx = tid & 15;
    LAS int* rowidx = (LAS int*)(sm + 16 * 132 + 2 * 16 * 128);
    LAS int* pairs = rowidx + 128;
    LAS int* gm = pairs + 128;
    const int nrows = (l == 0) ? RT : RL;
    const GroupMap G = build_group_map(p, l, gm, 128, nrows, tid);
    const bf16_t* HID = (const bf16_t*)(p->ws + WS_HID); bf16_t* ROWS = (bf16_t*)(p->ws + WS_ROWS);
    const uint2* LIST = (const uint2*)(p->ws + WS_LIST);
    const float* MOD = (const float*)(p->ws + WS_MOD) + (size_t)l * 9 * 6144;
    const int ntiles = G.tstart[65];
    for (int u = blockIdx.x; u < ntiles * 8; u += gridDim.x) {
        const int t = u >> 3, nt = u & 7;
        int e = 0; while (G.tstart[e + 1] <= t) ++e;
        const int m0 = (t - G.tstart[e]) * 128, cnt = G.cnt[e];
        __syncthreads();
        if (tid < 128) {
            const int m = m0 + tid;
            if (m < cnt) { rowidx[tid] = G.sbase[e] + m; pairs[tid] = e < 64 ? (int)LIST[(size_t)e * RT + m].x : m; }
            else { rowidx[tid] = -1; pairs[tid] = -1; }
        }
        __syncthreads();
        const float* Wd = e < 64 ? p->in[I_WDOWN] + ((size_t)l * NE + e) * DE * D : p->in[I_SDOWN] + (size_t)l * DE * D;
        float acc[4][8], acc2[4][8];
        sgemm_tile<true, false>(sm, HID, DE, rowidx, Wd, nullptr, D, nt * 128, DE, acc, acc2, tid);
#pragma unroll
        for (int i = 0; i < 4; ++i) { const int mi = ty * 4 + i; const int pr = pairs[mi];
            if (pr >= 0) {
                if (e < 64) { bf16_t* rp = ROWS + (size_t)pr * D + nt * 128 + tx * 8;
#pragma unroll
                    for (int j = 0; j < 8; ++j) rp[j] = f2bf(acc[i][j]); }
                else { const int bb = row_bb(pr); float* xw = xw_row(p, pr) + nt * 128 + tx * 8; const float* g2 = MOD + bb * 6144 + 5120 + nt * 128 + tx * 8;
#pragma unroll
                    for (int j = 0; j < 8; ++j) xw[j] += g2[j] * acc[i][j]; }
            } }
    }
}


#ifndef GP_ALIGN
#define GP_ALIGN true
#endif
#ifndef GP_SP2
#define GP_SP2 true
#endif
constexpr int GM_OFF = 131072;
__device__ __forceinline__ void tail_fill(KP p, LAS unsigned char* lds, int nU, int ql, int per_unit);
__device__ __forceinline__ void phase_inproj_fast(KP p, int l, LAS unsigned char* lds) {
    const int tid = opaque_tid();
    pg8::SchedDense S; S.K = D / 2; S.G = gridDim.x; S.c = blockIdx.x; S.Bt = (const char*)(p->ws + WS_WIN) + (size_t)l * DIN * D; S.nN = DIN / 256;
    if (l == 0) { S.nM = RT / 256; S.nExtra = 0; S.xpm0 = 0; S.xpn0 = 0; S.xn = 1; }
    else { S.nM = RL / 256; S.nExtra = (RC / 256) * 4; S.xpm0 = RL / 256; S.xpn0 = OFF_K / 256; S.xn = 4; }
    S.nwg = S.nM * S.nN;
    EpiInproj E{(bf16_t*)(p->ws + WS_PB)};
    pg8::gemm_phase<GP_ALIGN, false, false, true, 123>(lds, (const char*)(p->ws + (l == 0 ? WS_HB : WS_HID)), D / 2, S, E, tid);
    tail_fill(p, lds, S.nwg + S.nExtra, l, 4);
}
__device__ __forceinline__ void phase_outproj_fast(KP p, int l, LAS unsigned char* lds) {
    const int tid = opaque_tid();
    pg8::SchedDense S; S.K = D / 2; S.G = gridDim.x; S.c = blockIdx.x; S.Bt = (const char*)(p->ws + WS_WOUT) + (size_t)l * D * D; S.nN = D / 256;
    S.nM = (l == 0 ? RT : RL) / 256; S.nExtra = 0; S.xpm0 = 0; S.xpn0 = 0; S.xn = 1; S.nwg = S.nM * S.nN;
    EpiOutproj E{(bf16_t*)(p->ws + WS_Y)};
    pg8::gemm_phase<GP_ALIGN, false, false, true, 124>(lds, (const char*)(p->ws + WS_MIX), D / 2, S, E, tid);
    tail_fill(p, lds, S.nwg, l, 4);
}
__device__ __forceinline__ void phase_moe_up_fast(KP p, int l, LAS unsigned char* lds) {
    const int tid = opaque_tid();
    const int nrows = (l == 0) ? RT : RL;
    const GroupMap G = build_group_map(p, l, (LAS int*)(lds + GM_OFF), 256, nrows, tid);
    pg8::SchedMoe<true> S; S.tstart = G.tstart; S.sbase = G.sbase; S.cntv = G.cnt; S.NPN = 2; S.G = gridDim.x; S.c = blockIdx.x; S.nU = G.tstart[65] * 2; S.K = D / 2;
    S.Wbase = (const char*)(p->ws + WS_WEXP + (size_t)l * WEXP_LAYER); S.LIST = (const uint2*)(p->ws + WS_LIST);
    EpiMoeUp E{(const uint2*)(p->ws + WS_LIST), (bf16_t*)(p->ws + WS_HID)};
    pg8::gemm_phase<GP_ALIGN, false, true, true, 123>(lds, (const char*)(p->ws + WS_HB), D / 2, S, E, tid);
    if (l == 0) tail_fill(p, lds, S.nU, 1, 4);
}
__device__ __forceinline__ void phase_moe_down_fast(KP p, int l, LAS unsigned char* lds) {
    const int tid = opaque_tid();
    const int nrows = (l == 0) ? RT : RL;
    const GroupMap G = build_group_map(p, l, (LAS int*)(lds + GM_OFF), 256, nrows, tid);
    pg8::SchedMoe<false> S; S.tstart = G.tstart; S.sbase = G.sbase; S.cntv = G.cnt; S.NPN = 4; S.G = gridDim.x; S.c = blockIdx.x; S.nU = G.tstart[65] * 4; S.K = DE / 2;
    S.Wbase = (const char*)(p->ws + WS_WEXP + (size_t)l * WEXP_LAYER + WEXP_DOWN); S.LIST = (const uint2*)(p->ws + WS_LIST);
    EpiMoeDown E{(const uint2*)(p->ws + WS_LIST), (bf16_t*)(p->ws + WS_ROWS), p, (const float*)(p->ws + WS_MOD) + (size_t)l * 9 * 6144 + 5120};
    int Kd = DE / 2; asm volatile("" : "+s"(Kd));
    S.K = Kd;
    pg8::gemm_phase<GP_ALIGN, false, true, true, 123>(lds, (const char*)(p->ws + WS_HID), Kd, S, E, tid);
    if (l == 0) tail_fill(p, lds, S.nU, 1, 2);
}

constexpr int WSD_SCALE_B = 126;
static_assert(ROWS_SCALE == 8.0f, "WSD_SCALE_B encodes ROWS_SCALE");
constexpr int WSD_PITCH = 272, WSD_IMG = 512 * WSD_PITCH, WSD_TAB = WSD_IMG;
__device__ __forceinline__ void phase_moe_down_ws(KP p, int l, LAS char* lds) {
    typedef int i32x8 __attribute__((ext_vector_type(8)));
    const int tid = opaque_tid(), lane = tid & 63, wave = tid >> 6, r16 = lane & 15, kb = lane >> 4;
    const int nrows = (l == 0) ? RT : RL;
    const GroupMap G = build_group_map(p, l, (LAS int*)(lds + WSD_TAB), 256, nrows, tid);
    LAS int* istart = (LAS int*)(lds + WSD_TAB + 1024);
    if (tid < 64) {
        const int np = (G.cnt[tid] + 63) >> 6, nch = (np + 7) >> 3, ppc = nch ? (np + nch - 1) / nch : 0;
        int it = nch * 2, st = it;
#pragma unroll
        for (int o = 1; o < 64; o <<= 1) { const int a = __shfl_up(st, o); if (tid >= o) st += a; }
        istart[tid] = st - it; istart[66 + tid] = ppc;
        if (tid == 63) { const int nps = (nrows + 63) >> 6, nchs = (nps + 7) >> 3; istart[64] = st; istart[65] = st + nchs * 2; istart[66 + 64] = (nps + nchs - 1) / nchs; }
    }
    __syncthreads();
    const int nitems = istart[65];
    const uint2* LIST = (const uint2*)(p->ws + WS_LIST);
    const unsigned char* HID = (const unsigned char*)(p->ws + WS_HID);
    unsigned char* ROWS = (unsigned char*)(p->ws + WS_ROWS);
    const float* g2 = (const float*)(p->ws + WS_MOD) + (size_t)l * 9 * 6144 + 5120;
    for (int L = blockIdx.x; L < nitems; L += gridDim.x) {
        const int itx = pg8::xcd_remap(L, nitems);
        const int e = __builtin_popcountll(__ballot(istart[(lane) + 1] <= itx));
        const int loc = itx - istart[e], half = loc & 1, chunk = loc >> 1, ppc = istart[66 + e];
        const int cnt = G.cnt[e], sb = G.sbase[e];
        const int np = (cnt + 63) >> 6, p0 = chunk * ppc, p1 = (p0 + ppc < np) ? p0 + ppc : np;
        {
            const unsigned char* Wsrc = (const unsigned char*)(p->ws + WS_WEXP + (size_t)l * WEXP_LAYER + (size_t)e * WEXP_STRIDE + WEXP_DOWN) + (size_t)half * 512 * 256;
            pg8::u32x4 wv[16];
            int tq = tid; asm volatile("" : "+v"(tq));
#pragma unroll
            for (int i = 0; i < 16; ++i) { const int idx = tq + 512 * i, rho = idx >> 4, pc = idx & 15, ct = rho >> 4, c = rho & 15;
                const int col = 128 * (ct >> 3) + 32 * (c >> 2) + 4 * (ct & 7) + (c & 3);
                wv[i] = *(const pg8::u32x4*)(Wsrc + (size_t)col * 256 + pc * 16); }
            __syncthreads();
#pragma unroll
            for (int i = 0; i < 16; ++i) { const int idx = tq + 512 * i, rho = idx >> 4, pc = idx & 15; *(LAS pg8::u32x4*)(lds + rho * WSD_PITCH + pc * 16) = wv[i]; }
            __syncthreads();
        }
        const LAS char* wl = lds + r16 * WSD_PITCH + kb * 32;
        const int bb_sh = 0;
        for (int ps = p0 + wave; ps < p1; ps += NWAVES) {
            const int slot0 = ps * 64;
            i32x8 hf[4][2]; unsigned pr[4];
#pragma unroll
            for (int g = 0; g < 4; ++g) { const int slot = slot0 + g * 16 + r16; const unsigned char* hp = HID + (size_t)(sb + slot) * DE + kb * 32;
                const pg8::u32x4 a0 = *(const pg8::u32x4*)hp, a1 = *(const pg8::u32x4*)(hp + 16), b0 = *(const pg8::u32x4*)(hp + 128), b1 = *(const pg8::u32x4*)(hp + 144);
                hf[g][0] = (i32x8){(int)a0.x, (int)a0.y, (int)a0.z, (int)a0.w, (int)a1.x, (int)a1.y, (int)a1.z, (int)a1.w};
                hf[g][1] = (i32x8){(int)b0.x, (int)b0.y, (int)b0.z, (int)b0.w, (int)b1.x, (int)b1.y, (int)b1.z, (int)b1.w};
                pr[g] = e < 64 ? LIST[(size_t)e * RT + slot].x : (unsigned)(RT * 8 + slot); }
#define WSD_WFRAG(t) const LAS char* wp = wl + (g8 * 8 + (t)) * 16 * WSD_PITCH; \
                    const pg8::u32x4 w0 = *(const LAS pg8::u32x4*)wp, w1 = *(const LAS pg8::u32x4*)(wp + 16), w2 = *(const LAS pg8::u32x4*)(wp + 128), w3 = *(const LAS pg8::u32x4*)(wp + 144); \
                    const i32x8 wf0 = {(int)w0.x, (int)w0.y, (int)w0.z, (int)w0.w, (int)w1.x, (int)w1.y, (int)w1.z, (int)w1.w}; \
                    const i32x8 wf1 = {(int)w2.x, (int)w2.y, (int)w2.z, (int)w2.w, (int)w3.x, (int)w3.y, (int)w3.z, (int)w3.w};
            {
#pragma unroll 1
                for (int g8 = 0; g8 < 4; ++g8) {
                    int ow[4][8];
#pragma unroll
                    for (int t = 0; t < 8; ++t) { WSD_WFRAG(t)
#pragma unroll
                        for (int g = 0; g < 4; ++g) { f32x4 acc = {0.f, 0.f, 0.f, 0.f};
                            acc = __builtin_amdgcn_mfma_scale_f32_16x16x128_f8f6f4(wf0, hf[g][0], acc, 0, 0, 0, 123, 0, WSD_SCALE_B);
                            acc = __builtin_amdgcn_mfma_scale_f32_16x16x128_f8f6f4(wf1, hf[g][1], acc, 0, 0, 0, 123, 0, WSD_SCALE_B);
                            int w = 0; w = __builtin_amdgcn_cvt_pk_fp8_f32(acc[0], acc[1], w, false); w = __builtin_amdgcn_cvt_pk_fp8_f32(acc[2], acc[3], w, true); ow[g][t] = w; }
                        if (t & 1) __builtin_amdgcn_sched_barrier(0);
                    }
#pragma unroll
                    for (int g = 0; g < 4; ++g) { const int slot = slot0 + g * 16 + r16;
                        if (slot < cnt) { unsigned char* dst = ROWS + (size_t)pr[g] * D + half * 512 + g8 * 128 + kb * 32;
                            *(pg8::u32x4*)dst = (pg8::u32x4){(unsigned)ow[g][0], (unsigned)ow[g][1], (unsigned)ow[g][2], (unsigned)ow[g][3]};
                            *(pg8::u32x4*)(dst + 16) = (pg8::u32x4){(unsigned)ow[g][4], (unsigned)ow[g][5], (unsigned)ow[g][6], (unsigned)ow[g][7]}; } }
                }
            }
#undef WSD_WFRAG
        }
        (void)bb_sh;
    }
    __syncthreads();
    if (l == 0) tail_fill(p, (LAS unsigned char*)lds, nitems, 1, 2);
}
__device__ __forceinline__ void phase_convert(KP p, LAS unsigned char* lds, int nd, int ne, int l) {
    const int tid = opaque_tid();
    convert_weights(p, lds, nd, ne, l, tid);
}
constexpr int NCVT = 1560, CVT_WORD = 69632;
__device__ __forceinline__ int cvt_claim(KP p, LAS unsigned char* lds, int l, const int tid) {
    if (tid == 0) *(LAS int*)(lds + CVT_WORD) = (int)atomicAdd((unsigned*)(p->ws + WS_CTL) + CW_CVT + l * 64, 1u);
    __syncthreads();
    const int j = *(const LAS int*)(lds + CVT_WORD);
    __syncthreads();
    return j;
}
__device__ __forceinline__ void convert_queue(KP p, LAS unsigned char* lds, int l, int budget, const int tid) {
    const int w = tid >> 6, lane = tid & 63;
    int j = cvt_claim(p, lds, l, tid); if (j >= NCVT) return;
    CvtJob cur = cvt_job_expert(p, l, j);
    f32x4 r[16];
    cvt_load(cur, w, lane, r);
    int done = 0;
    for (;;) {
        __syncthreads();
        cvt_to_lds(lds, w, lane, r, cur.f8);
        __syncthreads();
        ++done;
        int jn = NCVT; if (budget < 0 || done < budget) jn = cvt_claim(p, lds, l, tid);
        const bool more = jn < NCVT;
        CvtJob nx = cur;
        if (more) { nx = cvt_job_expert(p, l, jn); cvt_load(nx, w, lane, r); }
        cvt_write_out(cur, lds, tid);
        if (!more) break;
        cur = nx;
    }
    __syncthreads();
}
__device__ __forceinline__ void tail_fill(KP p, LAS unsigned char* lds, int nU, int ql, int per_unit) {
    const int G = gridDim.x, c = blockIdx.x;
    const int mine = c < nU ? (nU - c + G - 1) / G : 0, mx = (nU + G - 1) / G;
    if (mine < mx) { const int tid = opaque_tid(); convert_queue(p, lds, ql, (mx - mine) * per_unit, tid); }
}

__device__ __forceinline__ void phase_router_fast(KP p, int l, char* lds) {
    using att::bf16x8; using att::f32x16;
    const int tid = opaque_tid(), lane = tid & 63, wave = tid >> 6;
    constexpr int APITCH = 2064, MAXSEL = 2048;
    char* A_lds = lds;
    float* red = (float*)(lds + 67584);
    unsigned* sel_pair = (unsigned*)(lds + 100352); float* sel_gate = (float*)(lds + 100352 + 4 * MAXSEL); unsigned* sel_eidx = (unsigned*)(lds + 100352 + 8 * MAXSEL);
    unsigned* lcnt = (unsigned*)(lds + 100352 + 12 * MAXSEL); unsigned* lbase = lcnt + 64;
    float* tk_keys = (float*)(lds + 100352 + 12 * MAXSEL + 1024); float* tk_slot = tk_keys + 32 * 64;
    const float* MOD = (const float*)(p->ws + WS_MOD) + (size_t)l * 9 * 6144;
    bf16_t* HB = (bf16_t*)(p->ws + WS_HB);
    const bf16_t* Y = (const bf16_t*)(p->ws + WS_Y);
    unsigned* counts = (unsigned*)(p->ws + WS_CTL) + CW_CNT + l * 64;
    uint2* LIST = (uint2*)(p->ws + WS_LIST);
    const bf16_t* WRT = (const bf16_t*)(p->ws + WS_WR) + (size_t)l * NE * D;
    const float* gn = p->in[I_GN2] + l * D;
    const float brt = p->in[I_BROUTER][l * NE + lane];
    const int nunits = ((l == 0) ? RT : RL) / 32;
    if (tid < 64) lcnt[tid] = 0u;
    __syncthreads();
    int it = 0;
    for (int u = blockIdx.x; u < nunits; u += gridDim.x, ++it) {
        const int r0 = u * 32, bb = row_bb(r0);
        f32x4 v[4][4]; uint2 yv[4][4];
#pragma unroll
        for (int i = 0; i < 4; ++i) { const bf16_t* yr = Y + (size_t)(r0 + 4 * wave + i) * D + lane * 4;
            if (l == 0) { const float* xr = xsrc_row(p, 0, r0 + 4 * wave + i) + lane * 4;
#pragma unroll
                for (int j = 0; j < 4; ++j) v[i][j] = __builtin_nontemporal_load((const f32x4*)(xr + 256 * j)); }
            else { const bf16_t* xb = (const bf16_t*)(p->ws + WS_X1B) + (size_t)(r0 + 4 * wave + i) * D + lane * 4;
#pragma unroll
                for (int j = 0; j < 4; ++j) { const uint2 w = *(const uint2*)(xb + 256 * j);
                    v[i][j] = (f32x4){__uint_as_float(w.x << 16), __uint_as_float(w.x & 0xffff0000u), __uint_as_float(w.y << 16), __uint_as_float(w.y & 0xffff0000u)}; } }
#pragma unroll
            for (int j = 0; j < 4; ++j) yv[i][j] = *(const uint2*)(yr + 256 * j); }
        f32x4 ga[4], sh[4], g1[4];
#pragma unroll
        for (int j = 0; j < 4; ++j) { const int c = lane * 4 + 256 * j; const f32x4 g = *(const f32x4*)(gn + c), s1 = *(const f32x4*)(MOD + bb * 6144 + 4096 + c);
            ga[j] = g * (1.0f + s1); sh[j] = *(const f32x4*)(MOD + bb * 6144 + 3072 + c); g1[j] = *(const f32x4*)(MOD + bb * 6144 + 2048 + c); }
#pragma unroll
        for (int i = 0; i < 4; ++i) {
            const int rl = 4 * wave + i;
            float ss = 0.f;
#pragma unroll
            for (int j = 0; j < 4; ++j) {
                const f32x4 yf = {__uint_as_float(yv[i][j].x << 16), __uint_as_float(yv[i][j].x & 0xffff0000u), __uint_as_float(yv[i][j].y << 16), __uint_as_float(yv[i][j].y & 0xffff0000u)};
                v[i][j] = v[i][j] + g1[j] * yf;
                { uint2 w1; w1.x = pg8::cvt_pk_bf16(v[i][j].x, v[i][j].y); w1.y = pg8::cvt_pk_bf16(v[i][j].z, v[i][j].w);
                    *(uint2*)((bf16_t*)Y + (size_t)(r0 + rl) * D + lane * 4 + 256 * j) = w1; }
                ss += v[i][j].x * v[i][j].x + v[i][j].y * v[i][j].y + v[i][j].z * v[i][j].z + v[i][j].w * v[i][j].w; }
            ss = wave_sum(ss);
            const float inv = rsqrtf(ss * (1.0f / D) + EPS);
#pragma unroll
            for (int j = 0; j < 4; ++j) { const int c = lane * 4 + 256 * j; const f32x4 h = v[i][j] * inv * ga[j] + sh[j];
                uint2 w; w.x = pg8::cvt_pk_bf16(h.x, h.y); w.y = pg8::cvt_pk_bf16(h.z, h.w);
                *(uint2*)(A_lds + rl * APITCH + c * 2) = w;
                int w8 = 0; w8 = __builtin_amdgcn_cvt_pk_fp8_f32(sat8<16>(h.x), sat8<16>(h.y), w8, false); w8 = __builtin_amdgcn_cvt_pk_fp8_f32(sat8<16>(h.z), sat8<16>(h.w), w8, true);
                *(int*)((unsigned char*)HB + (size_t)(r0 + rl) * D + c) = w8; }
        }
        __syncthreads();
        {
            const int nt = wave & 1, kq = wave >> 1, r32 = lane & 31, hh = lane >> 5;
            f32x16 acc = {};
            const bf16_t* Wt = WRT + (size_t)((nt * 4 + kq) * 16) * 512 + lane * 8;
            const char* Ap = A_lds + r32 * APITCH + (kq * 256 + hh * 8) * 2;
#pragma unroll
            for (int s = 0; s < 16; ++s) { const bf16x8 a = *(const bf16x8*)(Ap + s * 32); const bf16x8 b = *(const bf16x8*)(Wt + s * 512);
                acc = __builtin_amdgcn_mfma_f32_32x32x16_bf16(a, b, acc, 0, 0, 0); }
#pragma unroll
            for (int r = 0; r < 16; ++r) red[((kq * 2 + nt) * 32 + att::crow(r, hh)) * 32 + r32] = acc[r];
        }
        __syncthreads();
        {
            const int et = lane >> 5, ec = lane & 31;
            float score[4], key[4];
#pragma unroll
            for (int i = 0; i < 4; ++i) { const int rl = 4 * wave + i; float logit = 0.f;
#pragma unroll
                for (int kq = 0; kq < 4; ++kq) logit += red[((kq * 2 + et) * 32 + rl) * 32 + ec];
                score[i] = 1.0f / (1.0f + expf(-logit)); key[i] = score[i] + brt;
                tk_keys[(wave * 4 + i) * 64 + lane] = key[i]; if (lane < 8) tk_slot[(wave * 4 + i) * 8 + lane] = -1.0f; }
            asm volatile("s_waitcnt lgkmcnt(0)" ::: "memory");
            int rank[4] = {0, 0, 0, 0};
#pragma unroll 1
            for (int jq = 0; jq < 4; ++jq) {
#pragma unroll
                for (int j4 = 0; j4 < 4; ++j4)
#pragma unroll
                    for (int i = 0; i < 4; ++i) { const f32x4 kk = *(const f32x4*)(tk_keys + (wave * 4 + i) * 64 + jq * 16 + j4 * 4);
                        rank[i] += (kk.x > key[i]) + (kk.y > key[i]) + (kk.z > key[i]) + (kk.w > key[i]); }
            }
#pragma unroll
            for (int i = 0; i < 4; ++i) if (rank[i] < TOPK) tk_slot[(wave * 4 + i) * 8 + rank[i]] = score[i];
            asm volatile("s_waitcnt lgkmcnt(0)" ::: "memory");
#pragma unroll
            for (int i = 0; i < 4; ++i) {
                const int rl = 4 * wave + i, r = r0 + rl;
                const f32x4 s0 = *(const f32x4*)(tk_slot + (wave * 4 + i) * 8), s1 = *(const f32x4*)(tk_slot + (wave * 4 + i) * 8 + 4);
                float ssum = ((s0.x + s0.y) + (s0.z + s0.w)) + ((s1.x + s1.y) + (s1.z + s1.w)); int myrank = rank[i] < TOPK ? rank[i] : -1;
                const bool hole = fminf(fminf(fminf(s0.x, s0.y), fminf(s0.z, s0.w)), fminf(fminf(s1.x, s1.y), fminf(s1.z, s1.w))) < 0.f || __popcll(__ballot(rank[i] < TOPK)) != TOPK;
                if (__builtin_expect(hole, 0)) {
                    float kx = key[i]; ssum = 0.f; myrank = -1;
#pragma unroll 1
                    for (int k = 0; k < TOPK; ++k) {
                        const float mx = wave_max(kx);
                        const unsigned long long bal = __ballot(kx == mx);
                        const int win = __ffsll((long long)bal) - 1;
                        ssum += __shfl(score[i], win);
                        if (lane == win) { myrank = k; kx = -1e30f; }
                    }
                }
                if (myrank >= 0) {
                    const unsigned li = atomicAdd(&lcnt[lane], 1u);
                    const int sidx = ((it * 32 + rl) * 8 + myrank) & (MAXSEL - 1);
                    sel_pair[sidx] = (unsigned)(r * 8 + myrank); sel_gate[sidx] = score[i] / ssum * 2.5f; sel_eidx[sidx] = ((unsigned)lane << 16) | li;
                }
            }
        }
        __syncthreads();
    }
    if (tid < 64) lbase[tid] = atomicAdd(&counts[tid], lcnt[tid]);
    __syncthreads();
    const int nsel = it * 256;
    for (int s = tid; s < nsel; s += NTHREADS) { const unsigned ei = sel_eidx[s], e = ei >> 16, li = ei & 0xffffu;
        uint2 en; en.x = sel_pair[s]; en.y = __float_as_uint(sel_gate[s]);
        LIST[(size_t)e * RT + lbase[e] + li] = en; }
    __syncthreads();
}

__device__ __forceinline__ void phase_gmlp_fast(KP p, int l, char* lds) {
    using att::bf16x8;
    const int tid = opaque_tid(), lane = tid & 63, wave = tid >> 6, fr = lane & 15, fq = lane >> 4;
    bf16_t* PB = (bf16_t*)(p->ws + WS_PB); unsigned char* MIX = (unsigned char*)(p->ws + WS_MIX);
    constexpr int VPITCH = 272;
    char* VT = lds;
    const int nchunks = (l == 0 ? RT : RL) / 128;
    const bf16_t* WSB = (const bf16_t*)(p->ws + WS_WSB) + (size_t)l * 4 * 128 * 128;
    const float* gv = p->in[I_GV] + l * 256; const float* bs = p->in[I_BS] + l * 4 * 128;
    for (int ch = blockIdx.x; ch < nchunks; ch += gridDim.x) {
        const int r0 = ch * 128;
        uint2 vv[16];
#pragma unroll
        for (int i = 0; i < 16; ++i) vv[i] = *(const uint2*)(PB + (size_t)(r0 + 16 * wave + i) * DIN + OFF_AV + lane * 4);
        const f32x4 g4 = *(const f32x4*)(gv + lane * 4);
#pragma unroll
        for (int i = 0; i < 16; i += 2) {
            float a[2][4];
#pragma unroll
            for (int t = 0; t < 2; ++t) { a[t][0] = __uint_as_float(vv[i + t].x << 16); a[t][1] = __uint_as_float(vv[i + t].x & 0xffff0000u); a[t][2] = __uint_as_float(vv[i + t].y << 16); a[t][3] = __uint_as_float(vv[i + t].y & 0xffff0000u); }
            const float s0 = wave_sum(a[0][0] * a[0][0] + a[0][1] * a[0][1] + a[0][2] * a[0][2] + a[0][3] * a[0][3]);
            const float s1 = wave_sum(a[1][0] * a[1][0] + a[1][1] * a[1][1] + a[1][2] * a[1][2] + a[1][3] * a[1][3]);
            const float i0 = rsqrtf(s0 * (1.0f / 256.0f) + EPS), i1 = rsqrtf(s1 * (1.0f / 256.0f) + EPS);
#pragma unroll
            for (int j = 0; j < 4; ++j) *(unsigned*)(VT + (lane * 4 + j) * VPITCH + (16 * wave + i) * 2) = pg8::cvt_pk_bf16(a[0][j] * i0 * g4[j], a[1][j] * i1 * g4[j]);
        }
        __syncthreads();
        const int pp = 16 * wave + fr;
#pragma unroll 1
        for (int g = 0; g < 4; ++g) {
            bf16x8 bw[4];
#pragma unroll
            for (int s = 0; s < 4; ++s) bw[s] = *(const bf16x8*)(WSB + (size_t)(g * 128 + pp) * 128 + s * 32 + fq * 8);
            f32x4 acc[4];
#pragma unroll
            for (int dt = 0; dt < 4; ++dt) { acc[dt] = (f32x4){0.f, 0.f, 0.f, 0.f};
#pragma unroll
                for (int s = 0; s < 4; ++s) { const bf16x8 a = *(const bf16x8*)(VT + (g * 64 + dt * 16 + fr) * VPITCH + (s * 32 + fq * 8) * 2);
                    acc[dt] = __builtin_amdgcn_mfma_f32_16x16x32_bf16(a, bw[s], acc[dt], 0, 0, 0); } }
            const float bias = bs[g * 128 + pp];
#pragma unroll
            for (int dt = 0; dt < 4; ++dt) { const int c = g * 64 + dt * 16 + 4 * fq;
                const uint2 uw = *(const uint2*)(PB + (size_t)(r0 + pp) * DIN + OFF_AU + c);
                const float u0 = __uint_as_float(uw.x << 16), u1 = __uint_as_float(uw.x & 0xffff0000u), u2 = __uint_as_float(uw.y << 16), u3 = __uint_as_float(uw.y & 0xffff0000u);
                *(unsigned*)(MIX + (size_t)(r0 + pp) * D + c) = mix8_4(u0 * (acc[dt][0] + bias), u1 * (acc[dt][1] + bias), u2 * (acc[dt][2] + bias), u3 * (acc[dt][3] + bias)); }
        }
        __syncthreads();
    }
}

__device__ __forceinline__ void phase_combine_fast(KP p, int l) {
    typedef float f32x2v __attribute__((ext_vector_type(2)));
    const int tid = opaque_tid(), lane = tid & 63, gw = blockIdx.x * NWAVES + (tid >> 6), NGW = gridDim.x * NWAVES;
    const unsigned char* ROWS = (const unsigned char*)(p->ws + WS_ROWS);
    const bf16_t* Y = (const bf16_t*)(p->ws + WS_Y);
    const float* MOD = (const float*)(p->ws + WS_MOD) + (size_t)l * 9 * 6144;
    const float* MOD1 = (const float*)(p->ws + WS_MOD) + (size_t)9 * 6144;
    bf16_t* HB = (bf16_t*)(p->ws + WS_HID);
    const float* gn1 = p->in[I_GN1] + D;
    const int nrows = (l == 0) ? RT : RL;
    for (int r0 = gw; r0 < nrows; r0 += 2 * NGW) {
        uint4 rw[2][9]; f32x4 x[2][4]; uint4 yv[2][2];
#pragma unroll
        for (int q = 0; q < 2; ++q) { const int r = r0 + q * NGW; if (r < nrows) {
#pragma unroll
            for (int k = 0; k < 8; ++k) { const pg8::u32x4 t_ = __builtin_nontemporal_load((const pg8::u32x4*)(ROWS + ((size_t)r * 8 + k) * D + lane * 16)); rw[q][k] = make_uint4(t_.x, t_.y, t_.z, t_.w); }
            { const pg8::u32x4 t_ = __builtin_nontemporal_load((const pg8::u32x4*)(ROWS + ((size_t)RT * 8 + r) * D + lane * 16)); rw[q][8] = make_uint4(t_.x, t_.y, t_.z, t_.w); }
            yv[q][0] = *(const uint4*)(Y + (size_t)r * D + lane * 16); yv[q][1] = *(const uint4*)(Y + (size_t)r * D + lane * 16 + 8); } }
#pragma unroll
        for (int q = 0; q < 2; ++q) { const int r = r0 + q * NGW; if (r < nrows) {
            const int bb = row_bb(r); float* xw = p->out + (size_t)r * D + lane * 16;
            float s[16];
#pragma unroll
            for (int i = 0; i < 16; ++i) s[i] = 0.f;
#pragma unroll
            for (int k = 0; k < 9; ++k) { const unsigned w4[4] = {rw[q][k].x, rw[q][k].y, rw[q][k].z, rw[q][k].w};
#pragma unroll
                for (int i = 0; i < 4; ++i) { const f32x2v a = __builtin_amdgcn_cvt_pk_f32_fp8((int)w4[i], false), b = __builtin_amdgcn_cvt_pk_f32_fp8((int)w4[i], true);
                    s[4 * i] += a[0]; s[4 * i + 1] += a[1]; s[4 * i + 2] += b[0]; s[4 * i + 3] += b[1]; } }
            float ss = 0.f;
            const unsigned yw[8] = {yv[q][0].x, yv[q][0].y, yv[q][0].z, yv[q][0].w, yv[q][1].x, yv[q][1].y, yv[q][1].z, yv[q][1].w};
#pragma unroll
            for (int c4 = 0; c4 < 4; ++c4) { const f32x4 g = *(const f32x4*)(MOD + bb * 6144 + 5120 + lane * 16 + 4 * c4) * (1.0f / ROWS_SCALE);
                const f32x4 yf = {__uint_as_float(yw[2 * c4] << 16), __uint_as_float(yw[2 * c4] & 0xffff0000u), __uint_as_float(yw[2 * c4 + 1] << 16), __uint_as_float(yw[2 * c4 + 1] & 0xffff0000u)};
                x[q][c4] = yf + g * (f32x4){s[4 * c4], s[4 * c4 + 1], s[4 * c4 + 2], s[4 * c4 + 3]};
                if (l != 0) *(f32x4*)(xw + 4 * c4) = x[q][c4];
                else if (c4 & 1) {
                    uint4 w; w.x = pg8::cvt_pk_bf16(x[q][c4 - 1].x, x[q][c4 - 1].y); w.y = pg8::cvt_pk_bf16(x[q][c4 - 1].z, x[q][c4 - 1].w); w.z = pg8::cvt_pk_bf16(x[q][c4].x, x[q][c4].y); w.w = pg8::cvt_pk_bf16(x[q][c4].z, x[q][c4].w);
                    *(uint4*)((bf16_t*)(p->ws + WS_X1B) + (size_t)r * D + lane * 16 + 4 * (c4 - 1)) = w; }
                ss += x[q][c4].x * x[q][c4].x + x[q][c4].y * x[q][c4].y + x[q][c4].z * x[q][c4].z + x[q][c4].w * x[q][c4].w; }
            if (l == 0) {
                ss = wave_sum(ss);
                const float inv = rsqrtf(ss * (1.0f / D) + EPS);
                const int c = lane * 16; float h[16];
#pragma unroll
                for (int c4 = 0; c4 < 4; ++c4) { const f32x4 g = *(const f32x4*)(gn1 + c + 4 * c4), s1 = *(const f32x4*)(MOD1 + bb * 6144 + 1024 + c + 4 * c4), s0 = *(const f32x4*)(MOD1 + bb * 6144 + c + 4 * c4);
                    const f32x4 hv = x[q][c4] * inv * g * (1.0f + s1) + s0; h[4 * c4] = hv.x; h[4 * c4 + 1] = hv.y; h[4 * c4 + 2] = hv.z; h[4 * c4 + 3] = hv.w; }
                uint4 w0; int t8;
                t8 = 0; t8 = __builtin_amdgcn_cvt_pk_fp8_f32(sat8<16>(h[0]), sat8<16>(h[1]), t8, false); t8 = __builtin_amdgcn_cvt_pk_fp8_f32(sat8<16>(h[2]), sat8<16>(h[3]), t8, true); w0.x = (unsigned)t8;
                t8 = 0; t8 = __builtin_amdgcn_cvt_pk_fp8_f32(sat8<16>(h[4]), sat8<16>(h[5]), t8, false); t8 = __builtin_amdgcn_cvt_pk_fp8_f32(sat8<16>(h[6]), sat8<16>(h[7]), t8, true); w0.y = (unsigned)t8;
                t8 = 0; t8 = __builtin_amdgcn_cvt_pk_fp8_f32(sat8<16>(h[8]), sat8<16>(h[9]), t8, false); t8 = __builtin_amdgcn_cvt_pk_fp8_f32(sat8<16>(h[10]), sat8<16>(h[11]), t8, true); w0.z = (unsigned)t8;
                t8 = 0; t8 = __builtin_amdgcn_cvt_pk_fp8_f32(sat8<16>(h[12]), sat8<16>(h[13]), t8, false); t8 = __builtin_amdgcn_cvt_pk_fp8_f32(sat8<16>(h[14]), sat8<16>(h[15]), t8, true); w0.w = (unsigned)t8;
                *(uint4*)((unsigned char*)HB + (size_t)r * D + c) = w0;
            }
        } }
    }
}

__device__ __forceinline__ void phase_combine(KP p, int l) {
    const int tid = opaque_tid(), lane = tid & 63, gw = blockIdx.x * NWAVES + (tid >> 6), NGW = gridDim.x * NWAVES;
    const bf16_t* ROWS = (const bf16_t*)(p->ws + WS_ROWS);
    const float* MOD = (const float*)(p->ws + WS_MOD) + (size_t)l * 9 * 6144;
    const int nrows = (l == 0) ? RT : RL;
    for (int r = gw; r < nrows; r += NGW) {
        const int bb = row_bb(r); float* xw = xw_row(p, r);
#pragma unroll
        for (int j = 0; j < 4; ++j) {
            const int c = lane * 4 + 256 * j; float s0 = 0.f, s1 = 0.f, s2 = 0.f, s3 = 0.f;
#pragma unroll
            for (int k = 0; k < 8; ++k) { const uint2 w = *(const uint2*)(ROWS + ((size_t)r * 8 + k) * D + c);
                s0 += __uint_as_float(w.x << 16); s1 += __uint_as_float(w.x & 0xffff0000u); s2 += __uint_as_float(w.y << 16); s3 += __uint_as_float(w.y & 0xffff0000u); }
            const f32x4 g = *(const f32x4*)(MOD + bb * 6144 + 5120 + c); f32x4 x = *(const f32x4*)(xw + c);
            x.x += g.x * s0; x.y += g.y * s1; x.z += g.z * s2; x.w += g.w * s3;
            *(f32x4*)(xw + c) = x;
        }
    }
}

constexpr int LDS_BYTES = 147456;
__global__ void __launch_bounds__(NTHREADS, 2) mega_fwd(Params pv) {
    KP p = (KP)__builtin_amdgcn_kernarg_segment_ptr();
    extern __shared__ __attribute__((aligned(16))) unsigned char lds[];
    LAS float* sm = (LAS float*)lds;
    volatile LAS unsigned* misc = (volatile LAS unsigned*)(lds + LDS_BYTES - 64);
    if (threadIdx.x < 16) misc[threadIdx.x] = 0u;
    __syncthreads();
    (void)xcd_barrier_post((unsigned*)(pv.ws + WS_CTL) + CW_BAR, misc);
#define GRID_BAR() do { XcdBarrier b_; b_.bar = (unsigned*)(p->ws + WS_CTL) + CW_BAR; b_.x = xb_xcc_id(); b_.st = misc; xcd_barrier(b_); } while (0)
    phase_convert(p, (LAS unsigned char*)lds, 240, 0, 0);
    phase_mod(p, sm);
    GRID_BAR();
#define LAYER(l) do { \
        if (l == 0) { phase_norm1(p, l); GRID_BAR(); } \
        phase_inproj_fast(p, l, (LAS unsigned char*)lds); GRID_BAR(); \
        phase_gmlp_fast(p, l, (char*)lds); phase_mixers(p, l, sm, false); GRID_BAR(); \
        phase_attn_fast(p, l, (char*)lds); GRID_BAR(); \
        phase_outproj_fast(p, l, (LAS unsigned char*)lds); GRID_BAR(); \
        phase_router_fast(p, l, (char*)lds); { const int tq_ = opaque_tid(); convert_queue(p, (LAS unsigned char*)lds, l, -1, tq_); } GRID_BAR(); \
        phase_moe_up_fast(p, l, (LAS unsigned char*)lds); GRID_BAR(); \
        phase_moe_down_ws(p, l, (LAS char*)lds); GRID_BAR(); \
        phase_combine_fast(p, l); if (l == 0) GRID_BAR(); } while (0)
    LAYER(0);
    LAYER(1);
#undef LAYER
}

extern "C" void kernel_launch(void* const* d_in, const int* in_sizes, int n_in, void* d_out, int out_size, void* d_ws, size_t ws_size, hipStream_t stream) {
    static int grid = 0;
    if (grid == 0) {
        if (n_in != 29 || out_size != RL * D || ws_size < WS_END) { fprintf(stderr, "kernel_launch: unexpected shapes n_in %d out %d ws %zu\n", n_in, out_size, ws_size); grid = -1; return; }
        int dev = 0, cus = 0, per_cu = 0;
        if (hipGetDevice(&dev) != hipSuccess || hipDeviceGetAttribute(&cus, hipDeviceAttributeMultiprocessorCount, dev) != hipSuccess) { grid = -1; return; }
        if (hipFuncSetAttribute((const void*)mega_fwd, hipFuncAttributeMaxDynamicSharedMemorySize, LDS_BYTES) != hipSuccess) { grid = -1; return; }
        if (hipOccupancyMaxActiveBlocksPerMultiprocessor(&per_cu, (const void*)mega_fwd, NTHREADS, LDS_BYTES) != hipSuccess || per_cu < 1) { fprintf(stderr, "occupancy query: %d\n", per_cu); }
        (void)hipGetLastError();
        grid = cus;
    }
    if (grid < 0) return;
    if (hipMemsetAsync((char*)d_ws + WS_CTL, 0, CTL_ZERO_BYTES, stream) != hipSuccess) return;
    Params p{};
    for (int i = 0; i < 29; ++i) p.in[i] = (const float*)d_in[i];
    p.out = (float*)d_out; p.ws = (unsigned char*)d_ws;
    hipLaunchKernelGGL(mega_fwd, dim3(grid), dim3(NTHREADS), LDS_BYTES, stream, p);
}
```
